# Optimizing an MI355X kernel written in HIP

```python
import math
import jax, jax.numpy as jnp
from jax import lax
import numpy as np

D_MODEL = 1024
BATCH = 4
SEQ = 8192
DEPTH = 2

GRID_W = 64
HEAD_DIM = 64
NA_HEADS = 4
NA_WIN_ROWS = 8
NA_WIN_COLS = 16
SW_HEADS = 8
SW_KV_HEADS = 2
SW_WINDOW = 128
SW_BLOCK = 128
DIFF_HEADS = 4
DIFF_QK_DIM = HEAD_DIM // 2
DIFF_V_DIM = HEAD_DIM
DIFF_BLOCK = 128
D_FF = 4 * D_MODEL
N_BUCKETS = 32
MAX_DISTANCE = 128
LN_EPS = 1e-5
NEG = -1e30

A_W = NA_HEADS * HEAD_DIM
B_Q_W = SW_HEADS * HEAD_DIM
B_KV_W = SW_KV_HEADS * HEAD_DIM
C_QK_W = DIFF_HEADS * 2 * DIFF_QK_DIM
C_V_W = DIFF_HEADS * DIFF_V_DIM
IN_SPLITS = (A_W, A_W, A_W, B_Q_W, B_KV_W, B_KV_W, C_QK_W, C_QK_W, C_V_W)
IS_VALUE = (0, 0, 1, 0, 0, 1, 0, 0, 1)
IN_WIDTH = A_W * 3 + B_Q_W + 2 * B_KV_W + 2 * C_QK_W + C_V_W
MIX_WIDTH = A_W + B_Q_W + C_V_W

kernel_name = "hybrid_natten_swa_diffattn_encoder"


def layer_norm(x, g, b):
    xf = x.astype(jnp.float32)
    mu = jnp.mean(xf, axis=-1, keepdims=True)
    xc = xf - mu
    var = jnp.mean(xc * xc, axis=-1, keepdims=True)
    y = xc * lax.rsqrt(var + LN_EPS) * g.astype(jnp.float32) + b.astype(jnp.float32)
    return y.astype(x.dtype)


def t5_bucket(rel):
    nb = N_BUCKETS // 2
    max_exact = nb // 2
    n = jnp.abs(rel)
    nf = jnp.maximum(n, 1).astype(jnp.float32)
    large = max_exact + (jnp.log(nf / max_exact) / math.log(MAX_DISTANCE / max_exact)
                         * (nb - max_exact)).astype(jnp.int32)
    large = jnp.minimum(large, nb - 1)
    return jnp.where(rel > 0, nb, 0) + jnp.where(n < max_exact, n, large)


def neighbourhood_attention(q, k, v, rpb):
    b, s, h, d = q.shape
    rows = s // GRID_W
    wr = min(NA_WIN_ROWS, rows)
    qg = q.reshape(b, rows, GRID_W, h, d)
    kg = k.reshape(b, rows, GRID_W, h, d)
    vg = v.reshape(b, rows, GRID_W, h, d)
    r = jnp.arange(rows)
    row_start = jnp.clip(r - wr // 2, 0, rows - wr)
    row_idx = row_start[:, None] + jnp.arange(wr)[None, :]
    k_rows = kg[:, row_idx]
    v_rows = vg[:, row_idx]
    c = jnp.arange(GRID_W)
    col_start = jnp.clip(c - NA_WIN_COLS // 2, 0, GRID_W - NA_WIN_COLS)
    col_off = c[None, :] - col_start[:, None]
    col_mask = (col_off >= 0) & (col_off < NA_WIN_COLS)
    dr = row_idx - r[:, None]
    dc = jnp.clip(c[None, :] - c[:, None], -(NA_WIN_COLS - 1), NA_WIN_COLS - 1)
    bias = rpb[:, dr + NA_WIN_ROWS - 1][..., dc + NA_WIN_COLS - 1]
    bias = bias.transpose(0, 1, 3, 2, 4).astype(jnp.float32)
    scores = jnp.einsum('brqhd,brwkhd->bhrqwk', qg, k_rows).astype(jnp.float32) * (d ** -0.5)
    scores = jnp.where(col_mask[:, None, :], scores + bias[None], NEG)
    sh = scores.shape
    p = jax.nn.softmax(scores.reshape(sh[:-2] + (sh[-2] * sh[-1],)), axis=-1).reshape(sh)
    out = jnp.einsum('bhrqwk,brwkhd->brqhd', p.astype(v.dtype), v_rows)
    return out.reshape(b, s, h, d)


def sliding_window_gqa(q, k, v, sink, bias_table):
    b, s, hq, d = q.shape
    hkv = k.shape[2]
    g = hq // hkv
    nblk = s // SW_BLOCK
    pad = ((0, 0), (SW_BLOCK, SW_BLOCK), (0, 0), (0, 0))
    kp = jnp.pad(k, pad).reshape(b, nblk + 2, SW_BLOCK, hkv, d)
    vp = jnp.pad(v, pad).reshape(b, nblk + 2, SW_BLOCK, hkv, d)
    k_band = jnp.concatenate([kp[:, :-2], kp[:, 1:-1], kp[:, 2:]], axis=2)
    v_band = jnp.concatenate([vp[:, :-2], vp[:, 1:-1], vp[:, 2:]], axis=2)
    qb = q.reshape(b, nblk, SW_BLOCK, hkv, g, d)
    scores = jnp.einsum('bnqhgd,bnkhd->bnhgqk', qb, k_band).astype(jnp.float32) * (d ** -0.5)
    qi = jnp.arange(SW_BLOCK)
    kj = jnp.arange(3 * SW_BLOCK) - SW_BLOCK
    rel = kj[None, :] - qi[:, None]
    bias = bias_table[t5_bucket(rel)].astype(jnp.float32)
    bias = bias.transpose(2, 0, 1).reshape(hkv, g, SW_BLOCK, 3 * SW_BLOCK)
    kpos = jnp.arange(nblk)[:, None] * SW_BLOCK + kj[None, :]
    valid = ((jnp.abs(rel) <= SW_WINDOW)[None]
             & ((kpos >= 0) & (kpos < s))[:, None, :])
    scores = jnp.where(valid[None, :, None, None], scores + bias, NEG)
    sink_col = jnp.broadcast_to(sink.astype(jnp.float32).reshape(hkv, g, 1, 1),
                                scores.shape[:-1] + (1,))
    p = jax.nn.softmax(jnp.concatenate([scores, sink_col], axis=-1), axis=-1)[..., :-1]
    out = jnp.einsum('bnhgqk,bnkhd->bnqhgd', p.astype(v.dtype), v_band)
    return out.reshape(b, s, hq, d)


def differential_attention(q, k, v, lam_q, lam_k, subln_g, bias_table, lam_init):
    b, s, h, _, dqk = q.shape
    nblk = s // DIFF_BLOCK
    scale = dqk ** -0.5
    lqf = lam_q.astype(jnp.float32)
    lkf = lam_k.astype(jnp.float32)
    lam = (jnp.exp(jnp.sum(lqf[0] * lkf[0])) - jnp.exp(jnp.sum(lqf[1] * lkf[1]))
           + lam_init)
    kpos = jnp.arange(s)
    qb = jnp.moveaxis(q.reshape(b, nblk, DIFF_BLOCK, h, 2, dqk), 1, 0)

    def block(args):
        q_blk, i = args
        qpos = i * DIFF_BLOCK + jnp.arange(DIFF_BLOCK)
        rel = kpos[None, :] - qpos[:, None]
        bias = jnp.moveaxis(bias_table[t5_bucket(rel)], -1, 0).astype(jnp.float32)
        scores = jnp.einsum('bqhmd,bkhmd->bhmqk', q_blk, k).astype(jnp.float32) * scale
        p = jax.nn.softmax(scores + bias[None, :, None], axis=-1)
        attn = p[:, :, 0] - lam * p[:, :, 1]
        return jnp.einsum('bhqk,bkhd->bqhd', attn.astype(v.dtype), v)

    out = lax.map(block, (qb, jnp.arange(nblk)))
    out = jnp.moveaxis(out, 0, 1).reshape(b, s, h, v.shape[-1])
    of = out.astype(jnp.float32)
    of = of * lax.rsqrt(jnp.mean(of * of, axis=-1, keepdims=True) + LN_EPS)
    of = of * subln_g.astype(jnp.float32) * (1.0 - lam_init)
    return of.astype(v.dtype)


def setup_inputs(seed: int = 0) -> dict:
    key = jax.random.key(seed)
    ks = jax.random.split(key, 20)
    beta = (8 * DEPTH) ** -0.25
    nrm = jax.random.normal
    col_scale = jnp.concatenate([
        jnp.full((w,), beta if isv else 1.0, jnp.float32) for w, isv in zip(IN_SPLITS, IS_VALUE)])
    x = nrm(ks[0], (BATCH, SEQ, D_MODEL), jnp.float32)
    ln_in_g = 1.0 + 0.02 * nrm(ks[1], (D_MODEL,), jnp.float32)
    ln_in_b = 0.02 * nrm(ks[2], (D_MODEL,), jnp.float32)
    t5_table = 0.2 * nrm(ks[3], (N_BUCKETS, SW_HEADS + DIFF_HEADS), jnp.float32)
    w_in = nrm(ks[4], (DEPTH, D_MODEL, IN_WIDTH), jnp.float32) * (D_MODEL ** -0.5) * col_scale
    w_out = nrm(ks[5], (DEPTH, MIX_WIDTH, D_MODEL), jnp.float32) * (MIX_WIDTH ** -0.5) * beta
    na_rpb = 0.2 * nrm(ks[6], (DEPTH, NA_HEADS, 2 * NA_WIN_ROWS - 1, 2 * NA_WIN_COLS - 1), jnp.float32)
    sw_sink = 0.5 * nrm(ks[7], (DEPTH, SW_HEADS), jnp.float32)
    diff_lam_q = 0.1 * nrm(ks[8], (DEPTH, 2, DIFF_QK_DIM), jnp.float32)
    diff_lam_k = 0.1 * nrm(ks[9], (DEPTH, 2, DIFF_QK_DIM), jnp.float32)
    diff_subln_g = 1.0 + 0.02 * nrm(ks[10], (DEPTH, DIFF_V_DIM), jnp.float32)
    ln_mix_g = 1.0 + 0.02 * nrm(ks[11], (DEPTH, D_MODEL), jnp.float32)
    ln_mix_b = 0.02 * nrm(ks[12], (DEPTH, D_MODEL), jnp.float32)
    w_ff1 = nrm(ks[13], (DEPTH, D_MODEL, D_FF), jnp.float32) * (D_MODEL ** -0.5)
    w_ff2 = nrm(ks[14], (DEPTH, D_FF, D_MODEL), jnp.float32) * (D_FF ** -0.5) * beta
    ln_ff_g = 1.0 + 0.02 * nrm(ks[15], (DEPTH, D_MODEL), jnp.float32)
    ln_ff_b = 0.02 * nrm(ks[16], (DEPTH, D_MODEL), jnp.float32)
    return {"x": x, "ln_in_g": ln_in_g, "ln_in_b": ln_in_b, "t5_table": t5_table,
            "w_in": w_in, "w_out": w_out, "na_rpb": na_rpb, "sw_sink": sw_sink,
            "diff_lam_q": diff_lam_q, "diff_lam_k": diff_lam_k, "diff_subln_g": diff_subln_g,
            "ln_mix_g": ln_mix_g, "ln_mix_b": ln_mix_b, "w_ff1": w_ff1, "w_ff2": w_ff2,
            "ln_ff_g": ln_ff_g, "ln_ff_b": ln_ff_b}


def reference(x, ln_in_g, ln_in_b, t5_table, w_in, w_out, na_rpb, sw_sink,
              diff_lam_q, diff_lam_k, diff_subln_g, ln_mix_g, ln_mix_b,
              w_ff1, w_ff2, ln_ff_g, ln_ff_b):
    alpha = (2 * DEPTH) ** 0.25
    b, s, _ = x.shape
    split_points = np.cumsum(IN_SPLITS)[:-1].tolist()
    sw_table = t5_table[:, :SW_HEADS]
    diff_table = t5_table[:, SW_HEADS:]
    x = layer_norm(x, ln_in_g, ln_in_b)
    for l in range(DEPTH):
        lam_init = 0.8 - 0.6 * math.exp(-0.3 * l)
        proj = x @ w_in[l]
        qa, ka, va, qb, kb, vb, qc, kc, vc = jnp.split(proj, split_points, axis=-1)
        oa = neighbourhood_attention(
            qa.reshape(b, s, NA_HEADS, HEAD_DIM), ka.reshape(b, s, NA_HEADS, HEAD_DIM),
            va.reshape(b, s, NA_HEADS, HEAD_DIM), na_rpb[l])
        ob = sliding_window_gqa(
            qb.reshape(b, s, SW_HEADS, HEAD_DIM), kb.reshape(b, s, SW_KV_HEADS, HEAD_DIM),
            vb.reshape(b, s, SW_KV_HEADS, HEAD_DIM), sw_sink[l], sw_table)
        oc = differential_attention(
            qc.reshape(b, s, DIFF_HEADS, 2, DIFF_QK_DIM), kc.reshape(b, s, DIFF_HEADS, 2, DIFF_QK_DIM),
            vc.reshape(b, s, DIFF_HEADS, DIFF_V_DIM), diff_lam_q[l], diff_lam_k[l],
            diff_subln_g[l], diff_table, lam_init)
        mix = jnp.concatenate([oa.reshape(b, s, A_W), ob.reshape(b, s, B_Q_W),
                               oc.reshape(b, s, C_V_W)], axis=-1) @ w_out[l]
        x = layer_norm(alpha * x + mix, ln_mix_g[l], ln_mix_b[l])
        hdn = jax.nn.relu(x @ w_ff1[l])
        x = layer_norm(alpha * x + (hdn * hdn) @ w_ff2[l], ln_ff_g[l], ln_ff_b[l])
    return x
```

```cpp
#include <hip/hip_runtime.h>
#include <hip/hip_cooperative_groups.h>
#include <cstdio>
#include <cstdint>
namespace cg = cooperative_groups;
namespace pg8 {
#define PG8_LAS __attribute__((address_space(3)))
typedef unsigned short bf16_t;
typedef short bf16x8 __attribute__((ext_vector_type(8)));
typedef float f32x4 __attribute__((ext_vector_type(4)));
typedef unsigned u32x4 __attribute__((ext_vector_type(4)));
constexpr int BM = 256, BK = 64, HALF = 128, HTB = HALF * BK * 2  , STAGE_BYTES = 8 * HTB, NXCD = 8, WGM = 8;

__host__ __device__ __forceinline__ int lds_byte(int r, int c) { const int st = (r >> 4) * 2 + (c >> 5), rr = r & 15, cc = c & 31, ob = rr * 64 + cc * 2; return st * 1024 + (ob ^ (((ob >> 9) & 1) << 5)); }
__host__ __device__ __forceinline__ void stage_rc(int b, int& R, int& C) { const int st = b / 1024, sb = b % 1024, swz = sb ^ (((sb >> 9) & 1) << 5); R = (st >> 1) * 16 + swz / 64; C = (st & 1) * 32 + (swz % 64) / 2; }
__host__ __device__ __forceinline__ int perm32(int rho) { const int n = rho >> 4, i = rho & 15; return 8 * (i >> 2) + 4 * n + (i & 3); }

struct Unit { int pm, pn; };
struct Gemm { const bf16_t* A; const bf16_t* Bt; int M, N, K; };

struct StaticOrder {
    int nM, nN, nwg, G, c;
    __host__ __device__ void init(int M, int N, int G_, int c_) { nM = M / BM; nN = N / BM; nwg = nM * nN; G = G_; c = c_; }
    __host__ __device__ bool next(int i, Unit& u) const {
        const long L = (long)i * G + c; if (L >= nwg) return false;
        int wgid = (int)L; { const int q = nwg / NXCD, r = nwg % NXCD, xcd = wgid % NXCD, off = wgid / NXCD; wgid = (xcd < r ? xcd * (q + 1) : r * (q + 1) + (xcd - r) * q) + off; }
        const int nig = WGM * nN, gid = wgid / nig, fm = gid * WGM, gsz = (nM - fm) < WGM ? (nM - fm) : WGM;
        u.pm = fm + ((wgid % nig) % gsz); u.pn = (wgid % nig) / gsz; return true;
    }
    __device__ __forceinline__ void a_ready(const Unit&) const {}
    __device__ __forceinline__ void done(const Unit&) const {}
};

__device__ __forceinline__ unsigned cvt_pk_bf16(float lo, float hi) { unsigned r; asm volatile("v_cvt_pk_bf16_f32 %0, %1, %2" : "=v"(r) : "v"(lo), "v"(hi)); return r; }
typedef float f32x2 __attribute__((ext_vector_type(2)));
typedef unsigned u32x2 __attribute__((ext_vector_type(2)));
template <int MODE> struct EpiBf {
    static constexpr bool PERM = true, AFTER_DRAIN = false;
    bf16_t* O; int ldc; float sA, sC;
    __device__ __forceinline__ void operator()(const f32x4 (&acc)[2][2][4][2], const Unit& u, int wr, int wc, int fr, int fq) const {
        const int row0 = u.pm * BM + wr * 64 + fr, col0 = u.pn * BM + wc * 32 + 8 * fq;
        float sc = 1.f;
        if (MODE == 0) { const int pn = u.pn; sc = (pn == 0 || pn == 3 || pn == 4) ? sA : (pn == 6 ? sC : 1.f); }
#pragma unroll
        for (int ai = 0; ai < 2; ++ai)
#pragma unroll
            for (int m = 0; m < 4; ++m) { bf16_t* rowp = O + (size_t)(row0 + ai * HALF + m * 16) * ldc + col0;
#pragma unroll
                for (int bj = 0; bj < 2; ++bj) { f32x4 v0 = acc[ai][bj][m][0], v1 = acc[ai][bj][m][1];
                    if (MODE == 0) { v0 = v0 * sc; v1 = v1 * sc; }
                    else { v0 = __builtin_elementwise_max(v0, (f32x4){0.f, 0.f, 0.f, 0.f}); v1 = __builtin_elementwise_max(v1, (f32x4){0.f, 0.f, 0.f, 0.f}); v0 = v0 * v0; v1 = v1 * v1; }
                    u32x4 w; w.x = cvt_pk_bf16(v0[0], v0[1]); w.y = cvt_pk_bf16(v0[2], v0[3]); w.z = cvt_pk_bf16(v1[0], v1[1]); w.w = cvt_pk_bf16(v1[2], v1[3]);
                    *(u32x4*)(rowp + bj * HALF) = w; } }
    }
};
struct EpiResid {
    static constexpr bool PERM = false, AFTER_DRAIN = false;
    const float* X; float* Y; int ldc; float alpha;
    __device__ __forceinline__ void operator()(const f32x4 (&acc)[2][2][4][2], const Unit& u, int wr, int wc, int fr, int fq) const {
        const int row0 = u.pm * BM + wr * 64 + fr, col0 = u.pn * BM + wc * 32 + 4 * fq;
#pragma unroll
        for (int ai = 0; ai < 2; ++ai)
#pragma unroll
            for (int m = 0; m < 4; ++m) { const size_t off = (size_t)(row0 + ai * HALF + m * 16) * ldc + col0;
#pragma unroll
                for (int bj = 0; bj < 2; ++bj)
#pragma unroll
                    for (int n = 0; n < 2; ++n) { const f32x4 x = *(const f32x4*)(X + off + bj * HALF + n * 16); *(f32x4*)(Y + off + bj * HALF + n * 16) = x * alpha + acc[ai][bj][m][n]; }
                asm volatile("" ::: "memory"); }
    }
};
template <class Epi, class Sched, bool ALIGN_EPI = false, bool SP2 = false>
__device__ __forceinline__ void gemm_phase(PG8_LAS unsigned char* lds, const Gemm g, const Sched& S, const Epi& E) {
    int tid_ = threadIdx.x; asm volatile("" : "+v"(tid_));
    const int tid = tid_, wid = __builtin_amdgcn_readfirstlane(tid >> 6), lane = tid & 63, wr = wid >> 2, wc = wid & 3, fr = lane & 15, fq = lane >> 4;
    const int K = g.K, nt = K / BK;
    unsigned voffA[2], voffB[2];
#pragma unroll
    for (int i = 0; i < 2; ++i) { int R, C; stage_rc(tid * 16 + i * 8192, R, C); const int Rb = Epi::PERM ? ((R & ~31) + perm32(R & 31)) : R;
        voffA[i] = (unsigned)(R * K + C) * 2u; voffB[i] = (unsigned)(Rb * K + C) * 2u; }
    const size_t kstep = (size_t)(BK * 2);
    const size_t hstep = (size_t)HALF * K * 2;
    const size_t tstep = 2 * hstep;
    const unsigned ldsw = (unsigned)wid * 1024u;
    const int aoff = lds_byte(wr * 64 + fr, fq * 8), boff = lds_byte(wc * 32 + fr, fq * 8);
#define PG8_SA(b, h) (((b) * 2 + (h)) * HTB)
#define PG8_SB(b, h) ((4 + (b) * 2 + (h)) * HTB)
#define PG8_STAGE(bufoff, gbase, voff) do { _Pragma("unroll") for (int _i = 0; _i < 2; ++_i) \
        __builtin_amdgcn_global_load_lds((const unsigned*)((const char*)(gbase) + (voff)[_i]), (PG8_LAS unsigned*)(lds + (bufoff) + ldsw + _i * 8192), 16, 0, 0); } while (0)
#define PG8_LDA(dst, b, h) do { _Pragma("unroll") for (int m = 0; m < 4; ++m) _Pragma("unroll") for (int k = 0; k < 2; ++k) dst[m][k] = *(const PG8_LAS bf16x8*)(lds + PG8_SA(b, h) + aoff + m * 2048 + k * 1024); } while (0)
#define PG8_LDB(dst, b, h) do { _Pragma("unroll") for (int n = 0; n < 2; ++n) _Pragma("unroll") for (int k = 0; k < 2; ++k) dst[n][k] = *(const PG8_LAS bf16x8*)(lds + PG8_SB(b, h) + boff + n * 2048 + k * 1024); } while (0)
#define PG8_MMA(ai, bj, At, Bt) do { __builtin_amdgcn_s_setprio(1); _Pragma("unroll") for (int m = 0; m < 4; ++m) _Pragma("unroll") for (int n = 0; n < 2; ++n) _Pragma("unroll") for (int k = 0; k < 2; ++k) \
        acc[ai][bj][m][n] = __builtin_amdgcn_mfma_f32_16x16x32_bf16(Bt[n][k], At[m][k], acc[ai][bj][m][n], 0, 0, 0); __builtin_amdgcn_s_setprio(0); } while (0)
#define PG8_WAIT_V(n) asm volatile("s_waitcnt vmcnt(" #n ")" ::: "memory")
#define PG8_WAIT_L(n) asm volatile("s_waitcnt lgkmcnt(" #n ")" ::: "memory")
#define PG8_BAR __builtin_amdgcn_s_barrier()
#define PG8_SCHED __builtin_amdgcn_sched_barrier(0)
    Unit cur, nxt; int ui = 0;
    if (!S.next(0, cur)) return;
    f32x4 acc[2][2][4][2];
#pragma unroll
    for (int a = 0; a < 2; ++a)
#pragma unroll
        for (int b = 0; b < 2; ++b)
#pragma unroll
            for (int m = 0; m < 4; ++m)
#pragma unroll
                for (int n = 0; n < 2; ++n) acc[a][b][m][n] = (f32x4){0.f, 0.f, 0.f, 0.f};
    bf16x8 At[4][2], B0[2][2], B1[2][2];
    const char* cA = (const char*)g.A + (size_t)cur.pm * tstep; const char* cB = (const char*)g.Bt + (size_t)cur.pn * tstep;
    S.a_ready(cur);
    if constexpr (SP2) {
        PG8_STAGE(PG8_SB(0, 0), cB, voffB); PG8_STAGE(PG8_SB(0, 1), cB + hstep, voffB); PG8_STAGE(PG8_SA(0, 0), cA, voffA); PG8_STAGE(PG8_SA(0, 1), cA + hstep, voffA);
        if (wr == 1) PG8_BAR;
        PG8_WAIT_V(2); PG8_BAR;
        PG8_STAGE(PG8_SB(1, 0), cB + kstep, voffB); PG8_STAGE(PG8_SA(1, 0), cA + kstep, voffA); PG8_STAGE(PG8_SB(1, 1), cB + hstep + kstep, voffB);
        PG8_WAIT_V(6); PG8_BAR;
    } else {
        PG8_STAGE(PG8_SB(0, 0), cB, voffB); PG8_STAGE(PG8_SA(0, 0), cA, voffA); PG8_STAGE(PG8_SB(0, 1), cB + hstep, voffB); PG8_STAGE(PG8_SA(0, 1), cA + hstep, voffA);
        if (wr == 1) PG8_BAR;
        PG8_WAIT_V(4); PG8_BAR;
        PG8_STAGE(PG8_SB(1, 0), cB + kstep, voffB); PG8_STAGE(PG8_SA(1, 0), cA + kstep, voffA); PG8_STAGE(PG8_SB(1, 1), cB + hstep + kstep, voffB);
        PG8_WAIT_V(6); PG8_BAR;
    }
    for (;;) {
        const bool has_next = S.next(ui + 1, nxt);
        const char* nA = has_next ? (const char*)g.A + (size_t)nxt.pm * tstep : cA; const char* nB = has_next ? (const char*)g.Bt + (size_t)nxt.pn * tstep : cB;
        for (int t = 0; t < nt; t += 2) {
            const bool last = (t == nt - 2);
            const char* a1 = cA + (size_t)(t + 1) * kstep;
            const char* a2 = last ? nA : cA + (size_t)(t + 2) * kstep; const char* b2 = last ? nB : cB + (size_t)(t + 2) * kstep;
            const char* a3 = a2 + kstep; const char* b3 = b2 + kstep;
            if (last && has_next) S.a_ready(nxt);
            if constexpr (SP2) {
            PG8_LDB(B0, 0, 0); PG8_LDB(B1, 0, 1); PG8_SCHED; PG8_LDA(At, 0, 0); PG8_STAGE(PG8_SA(1, 1), a1 + hstep, voffA);
            PG8_WAIT_V(8); PG8_WAIT_L(0); PG8_BAR; PG8_MMA(0, 0, At, B0); PG8_MMA(0, 1, At, B1); PG8_BAR; PG8_SCHED;
            PG8_LDA(At, 0, 1); PG8_STAGE(PG8_SB(0, 0), b2, voffB); PG8_STAGE(PG8_SB(0, 1), b2 + hstep, voffB); PG8_STAGE(PG8_SA(0, 0), a2, voffA);
            PG8_WAIT_V(8); PG8_WAIT_L(0); PG8_BAR; PG8_MMA(1, 0, At, B0); PG8_MMA(1, 1, At, B1); PG8_BAR; PG8_SCHED;
            PG8_LDB(B0, 1, 0); PG8_LDB(B1, 1, 1); PG8_SCHED; PG8_LDA(At, 1, 0); PG8_STAGE(PG8_SA(0, 1), a2 + hstep, voffA);
            PG8_WAIT_V(8); PG8_WAIT_L(0); PG8_BAR; PG8_MMA(0, 0, At, B0); PG8_MMA(0, 1, At, B1); PG8_BAR; PG8_SCHED;
            PG8_LDA(At, 1, 1); PG8_STAGE(PG8_SB(1, 0), b3, voffB); PG8_STAGE(PG8_SB(1, 1), b3 + hstep, voffB); PG8_STAGE(PG8_SA(1, 0), a3, voffA);
            PG8_WAIT_V(8); PG8_WAIT_L(0); PG8_BAR; PG8_MMA(1, 0, At, B0); PG8_MMA(1, 1, At, B1); PG8_BAR; PG8_SCHED;
            } else {
            PG8_LDB(B0, 0, 0); PG8_SCHED; PG8_LDA(At, 0, 0); PG8_STAGE(PG8_SA(1, 1), a1 + hstep, voffA);
            PG8_WAIT_L(8); PG8_BAR; PG8_WAIT_L(0); PG8_MMA(0, 0, At, B0); PG8_BAR; PG8_SCHED;
            PG8_LDB(B1, 0, 1); PG8_STAGE(PG8_SB(0, 0), b2, voffB);
            PG8_BAR; PG8_WAIT_L(0); PG8_MMA(0, 1, At, B1); PG8_BAR;
            PG8_LDA(At, 0, 1); PG8_STAGE(PG8_SA(0, 0), a2, voffA);
            PG8_BAR; PG8_WAIT_L(0); PG8_MMA(1, 0, At, B0); PG8_BAR; PG8_SCHED;
            PG8_STAGE(PG8_SB(0, 1), b2 + hstep, voffB);
            PG8_WAIT_V(6); PG8_BAR; PG8_MMA(1, 1, At, B1); PG8_BAR;
            PG8_LDB(B0, 1, 0); PG8_SCHED; PG8_LDA(At, 1, 0); PG8_STAGE(PG8_SA(0, 1), a2 + hstep, voffA);
            PG8_WAIT_L(8); PG8_BAR; PG8_WAIT_L(0); PG8_MMA(0, 0, At, B0); PG8_BAR; PG8_SCHED;
            PG8_LDB(B1, 1, 1); PG8_STAGE(PG8_SB(1, 0), b3, voffB);
            PG8_BAR; PG8_WAIT_L(0); PG8_MMA(0, 1, At, B1); PG8_BAR;
            PG8_LDA(At, 1, 1); PG8_STAGE(PG8_SA(1, 0), a3, voffA);
            PG8_BAR; PG8_WAIT_L(0); PG8_MMA(1, 0, At, B0); PG8_BAR; PG8_SCHED;
            PG8_STAGE(PG8_SB(1, 1), b3 + hstep, voffB);
            PG8_WAIT_V(6); PG8_BAR; PG8_MMA(1, 1, At, B1); PG8_BAR;
            }
        }
        if constexpr (ALIGN_EPI) { if (wr == 0) PG8_BAR; }
        if constexpr (!Epi::AFTER_DRAIN) { E(acc, cur, wr, wc, fr, fq); S.done(cur); }
        if (!has_next) break;
#pragma unroll
        for (int a = 0; a < 2; ++a)
#pragma unroll
            for (int b = 0; b < 2; ++b)
#pragma unroll
                for (int m = 0; m < 4; ++m)
#pragma unroll
                    for (int n = 0; n < 2; ++n) acc[a][b][m][n] = (f32x4){0.f, 0.f, 0.f, 0.f};
        cur = nxt; cA = nA; cB = nB; ++ui;
        if constexpr (ALIGN_EPI) { if (wr == 1) PG8_BAR; }
    }
    PG8_WAIT_V(0);
    if constexpr (!ALIGN_EPI) { if (wr == 0) PG8_BAR; }
    PG8_BAR;
    if constexpr (Epi::AFTER_DRAIN) { E.fused(acc, cur, wr, wc, fr, fq, lds, wid, lane); S.done(cur); }
#undef PG8_SA
#undef PG8_SB
#undef PG8_STAGE
#undef PG8_LDA
#undef PG8_LDB
#undef PG8_MMA
#undef PG8_WAIT_V
#undef PG8_WAIT_L
#undef PG8_BAR
#undef PG8_SCHED
}
}

constexpr int BATCH = 4, SEQ = 8192, DM = 1024, MTOK = BATCH * SEQ, NPROJ = 2304, FF = 4096, DEPTH = 2;
constexpr float LN_EPS = 1e-5f, LOG2E = 1.4426950408889634f;
constexpr int NWAVES = 8;
#define GAS __attribute__((address_space(1)))
#define LAS __attribute__((address_space(3)))
typedef unsigned short bf16;
typedef unsigned v4u __attribute__((ext_vector_type(4)));
typedef float f32x4 __attribute__((ext_vector_type(4)));
#define LDS_WAIT() asm volatile("s_waitcnt lgkmcnt(0)" ::: "memory")
#define VM_WAIT() asm volatile("s_waitcnt vmcnt(0)" ::: "memory")
__device__ __forceinline__ unsigned f2bf(float f) { unsigned u = __builtin_bit_cast(unsigned, f); return (u + 0x7fffu + ((u >> 16) & 1u)) >> 16; }
__device__ __forceinline__ unsigned pk2(float lo, float hi) { return f2bf(lo) | (f2bf(hi) << 16); }

constexpr size_t MiB = 1u << 20;
constexpr size_t WS_CTL = 0;
constexpr size_t WS_WIN = 1 * MiB;
constexpr size_t WS_WOUT = 10 * MiB;
constexpr size_t WS_WFF1 = 14 * MiB;
constexpr size_t WS_WFF2 = 30 * MiB;
constexpr size_t WS_X = 48 * MiB;
constexpr size_t WS_XN = 176 * MiB;
constexpr size_t WS_H = 240 * MiB;
constexpr size_t WS_PROJ = 240 * MiB;
constexpr size_t WS_MIX = 384 * MiB;
constexpr size_t WS_END = 496 * MiB;

namespace att {
typedef short bf16x8 __attribute__((ext_vector_type(8)));
typedef short s16x4 __attribute__((ext_vector_type(4)));
typedef float f32x16 __attribute__((ext_vector_type(16)));
typedef unsigned u32x2 __attribute__((ext_vector_type(2)));
constexpr int PITCH = NPROJ;
constexpr int SLOTB = 16384, NSLOT = 3;
constexpr int L_RING = 0, L_SCR = 49152, L_LUTB = 81920, L_LUTC = 94208, L_RPB = 98560, L_PAR = 106240, L_END = 106752;
constexpr int LUTB_W = 383, LUTC_W = 257;
constexpr float NEGBIG = -1e30f;
constexpr int THR = 6;
__device__ __forceinline__ int crow(int r, int hi) { return (r & 3) + 8 * (r >> 2) + 4 * hi; }
__device__ __forceinline__ void glds16(const void* gsrc, unsigned lds_dst) { unsigned keep;
    asm volatile("s_mov_b32 %0, m0\n\ts_mov_b32 m0, %2\n\ts_nop 0\n\tglobal_load_lds_dwordx4 %1, off\n\ts_mov_b32 m0, %0" : "=&s"(keep) : "v"(gsrc), "s"(lds_dst) : "memory"); }
typedef float f32x2_t __attribute__((ext_vector_type(2))); typedef __bf16 bf16x2_t __attribute__((ext_vector_type(2)));
__device__ __forceinline__ unsigned cvtpk(float lo, float hi) { f32x2_t v = {lo, hi}; bf16x2_t b = __builtin_convertvector(v, bf16x2_t); return __builtin_bit_cast(unsigned, b); }
typedef short v4i16_t __attribute__((ext_vector_type(4)));
__device__ __forceinline__ s16x4 vtr(const LAS char* p) { return __builtin_bit_cast(s16x4, __builtin_amdgcn_ds_read_tr16_b64_v4i16((LAS v4i16_t*)p)); }
__device__ __forceinline__ float swapmax(float m) { auto rr = __builtin_amdgcn_permlane32_swap(__float_as_uint(m), __float_as_uint(m), false, false); return fmaxf(__uint_as_float(rr[0]), __uint_as_float(rr[1])); }
__device__ __forceinline__ float swapsum(float m) { auto rr = __builtin_amdgcn_permlane32_swap(__float_as_uint(m), __float_as_uint(m), false, false); return __uint_as_float(rr[0]) + __uint_as_float(rr[1]); }
__device__ __forceinline__ int t5_bucket(int rel) {
    const int n = rel < 0 ? -rel : rel;
    const int b = n < 8 ? n : n < 12 ? 8 : n < 16 ? 9 : n < 23 ? 10 : n < 32 ? 11 : n < 46 ? 12 : n < 64 ? 13 : n < 91 ? 14 : 15;
    return b + (rel > 0 ? 16 : 0);
}
__device__ __forceinline__ void build_tables(LAS char* lds, const float* t5, const float* rpb, const float* sink, const float* lq, const float* lk, const float* g, int layer) {
    const int tid = threadIdx.x;
    LAS float* lutB = (LAS float*)(lds + L_LUTB); LAS float* lutC = (LAS float*)(lds + L_LUTC); LAS float* rp = (LAS float*)(lds + L_RPB); LAS float* par = (LAS float*)(lds + L_PAR);
    for (int i = tid; i < 8 * LUTB_W; i += 512) { const int h = i / LUTB_W, rel = i % LUTB_W - 191; const int a = rel < 0 ? -rel : rel;
        lutB[i] = a <= 128 ? t5[t5_bucket(rel) * 12 + h] * LOG2E : NEGBIG; }
    for (int i = tid; i < 4 * LUTC_W; i += 512) { const int h = i / LUTC_W, rel = i % LUTC_W - 128; lutC[i] = t5[t5_bucket(rel) * 12 + 8 + h] * LOG2E; }
    for (int i = tid; i < 4 * 15 * 31; i += 512) rp[i] = rpb[i] * LOG2E;
    if (tid < 64) {
        const int l = tid; float p0 = 0.f, p1 = 0.f;
        if (l < 32) { p0 = lq[l] * lk[l]; p1 = lq[32 + l] * lk[32 + l]; }
#pragma unroll
        for (int o = 1; o < 64; o <<= 1) { p0 += __shfl_xor(p0, o); p1 += __shfl_xor(p1, o); }
        const float lam_init = layer == 0 ? 0.2f : 0.35550906759097f;
        if (l == 0) { par[0] = expf(p0) - expf(p1) + lam_init; par[1] = 1.f - lam_init; }
        if (l < 8) par[8 + l] = sink[l] * LOG2E;
        par[16 + l] = g[l];
    }
    LDS_WAIT(); __syncthreads();
}

template <int MODE> __device__ __forceinline__ void attn_unit(LAS char* lds, const bf16* PROJ, bf16* MIX, int b, int hh, int blk) {
    int tid_ = threadIdx.x; asm volatile("" : "+v"(tid_));
    const int tid = tid_, lane = tid & 63, r32 = lane & 31, hi = lane >> 5; const int wid = __builtin_amdgcn_readfirstlane(tid >> 6);
    constexpr int KS = (MODE == 2) ? 2 : 4;
    const long rowbase = (long)b * SEQ;
    int qrow0, qcol, kcol, vcol, ocol, t0, t1, kc0 = 0, myl = 0, hq = hh;
    if (MODE == 0) { const int r = 4 * blk + (wid >> 1); qrow0 = 64 * r + 32 * (wid & 1); qcol = hh * 64; kcol = 256 + hh * 64; vcol = 512 + hh * 64; ocol = hh * 64;
        const int lo = min(max(4 * blk - 4, 0), 120), hi_ = min(max(4 * blk - 1, 0), 120); t0 = lo; t1 = hi_ + 8; myl = min(max(r - 4, 0), 120); }
    else if (MODE == 1) { hq = hh * 4 + (wid >> 1); qrow0 = 64 * blk + 32 * (wid & 1); qcol = 768 + hq * 64; kcol = 1280 + hh * 64; vcol = 1408 + hh * 64; ocol = 256 + hq * 64;
        t0 = max(0, blk - 2); t1 = min(SEQ / 64, blk + 3); }
    else { const int m = wid >> 2; qrow0 = 128 * blk + 32 * (wid & 3); qcol = 1536 + hh * 64 + 32 * m; kcol = 1792 + hh * 64; vcol = 2048 + hh * 64; ocol = 768 + hh * 64; kc0 = 4 * m; t0 = 0; t1 = SEQ / 64; }
    const LAS float* lutB = (const LAS float*)(lds + L_LUTB); const LAS float* lutC = (const LAS float*)(lds + L_LUTC); const LAS float* rp = (const LAS float*)(lds + L_RPB); const LAS float* par = (const LAS float*)(lds + L_PAR);
    const bf16* ksrc = PROJ + (rowbase + lane) * PITCH + kcol + wid * 8;
    const bf16* vsrc = PROJ + (rowbase + 16 * (wid & 3) + (lane >> 2)) * PITCH + vcol + (wid >> 2) * 32 + (lane & 3) * 8;
    const unsigned ring0 = (unsigned)(uintptr_t)(lds + L_RING);
    const unsigned kdst = ring0 + wid * 1024, vdst = ring0 + 8192 + wid * 1024;
#define DMA_TILE(t, slot) do { glds16(ksrc + (long)(t) * 64 * PITCH, (unsigned)__builtin_amdgcn_readfirstlane(kdst + (slot) * SLOTB)); glds16(vsrc + (long)(t) * 64 * PITCH, (unsigned)__builtin_amdgcn_readfirstlane(vdst + (slot) * SLOTB)); } while (0)
    bf16x8 qr[KS];
    { const bf16* qp = PROJ + (rowbase + qrow0 + r32) * PITCH + qcol + 8 * hi;
#pragma unroll
      for (int ks = 0; ks < KS; ++ks) qr[ks] = *(const bf16x8*)(qp + 16 * ks); }
    DMA_TILE(t0, 0); if (t0 + 1 < t1) DMA_TILE(t0 + 1, 1);
    float mhat = 0.f, lsum = 0.f; f32x16 o[2]; o[0] = f32x16{}; o[1] = f32x16{};
    bool first = true;
    if (MODE == 1) { mhat = par[8 + hq]; lsum = hi == 0 ? 1.f : 0.f; first = false; }
    const LAS char* kfrag0 = lds + L_RING + (kc0 + hi) * 1024 + r32 * 16;
    const LAS char* vfrag0 = lds + L_RING + 8192 + ((lane >> 4) & 1) * 32 + (lane & 3) * 8 + (4 * hi + ((lane & 15) >> 2)) * 64;
    float cL = 0.f, cR = 0.f;
    if (MODE == 2) { cL = lutC[hh * LUTC_W + 0]; cR = lutC[hh * LUTC_W + 256]; }
    int slot = 0;
    for (int t = t0; t < t1; ++t) {
        if (t + 1 < t1) asm volatile("s_waitcnt vmcnt(2)" ::: "memory"); else asm volatile("s_waitcnt vmcnt(0)" ::: "memory");
        __builtin_amdgcn_s_barrier(); asm volatile("" ::: "memory");
        if (t + 2 < t1) { const int s2 = slot == 0 ? 2 : slot - 1; DMA_TILE(t + 2, s2); }
        const bool mine = (MODE != 0) || (t >= myl && t < myl + 8);
        if (mine) {
            const LAS char* kf = kfrag0 + slot * SLOTB; const LAS char* vf = vfrag0 + slot * SLOTB;
            f32x16 s0, s1;
            if (MODE == 2) {
                const int k0 = 64 * t, dlt = k0 - qrow0;
                if (dlt <= -154 || dlt >= 122) { const float c = (dlt < 0 ? cL : cR) - mhat;
#pragma unroll
                    for (int r = 0; r < 16; ++r) { s0[r] = c; s1[r] = c; } }
                else { const int lb = dlt - r32 + 4 * hi + 128;
#pragma unroll
                    for (int r = 0; r < 16; ++r) { const int c_r = (r & 3) + 8 * (r >> 2);
                        s0[r] = lutC[hh * LUTC_W + min(max(lb + c_r, 0), 256)] - mhat; s1[r] = lutC[hh * LUTC_W + min(max(lb + c_r + 32, 0), 256)] - mhat; } }
            } else if (MODE == 1) {
                const int lb = 64 * (t - blk) - 32 * (wid & 1) - r32 + 4 * hi + 191;
#pragma unroll
                for (int r = 0; r < 16; ++r) { const int c_r = (r & 3) + 8 * (r >> 2); s0[r] = lutB[hq * LUTB_W + lb + c_r] - mhat; s1[r] = lutB[hq * LUTB_W + lb + c_r + 32] - mhat; }
            } else {
                const int r_ = 4 * blk + (wid >> 1), dr = t - r_; const int cq = 32 * (wid & 1) + r32, cs = min(max(cq - 8, 0), 48);
                const int tb = 4 * hi - cs, eq = 15 - (cq - cs); const LAS float* rrow = rp + (hh * 15 + dr + 7) * 31;
#pragma unroll
                for (int r = 0; r < 16; ++r) { const int c_r = (r & 3) + 8 * (r >> 2);
                    const int ta = tb + c_r, tb2 = ta + 32;
                    const float va = rrow[min(max(ta + eq, 0), 30)], vb = rrow[min(max(tb2 + eq, 0), 30)];
                    s0[r] = ((unsigned)ta < 16u) ? va - mhat : NEGBIG; s1[r] = ((unsigned)tb2 < 16u) ? vb - mhat : NEGBIG; }
            }
#pragma unroll
            for (int ks = 0; ks < KS; ++ks) {
                const bf16x8 a0 = *(const LAS bf16x8*)(kf + ks * 2048), a1 = *(const LAS bf16x8*)(kf + ks * 2048 + 512);
                s0 = __builtin_amdgcn_mfma_f32_32x32x16_bf16(a0, qr[ks], s0, 0, 0, 0); s1 = __builtin_amdgcn_mfma_f32_32x32x16_bf16(a1, qr[ks], s1, 0, 0, 0); }
            float rm = fmaxf(s0[0], s1[0]);
#pragma unroll
            for (int r = 1; r < 16; ++r) rm = fmaxf(fmaxf(rm, s0[r]), s1[r]);
            rm = swapmax(rm);
            if (first || __any(rm > (float)THR)) {
                const float dl = first ? rm : fmaxf(rm, 0.f); mhat += dl;
#pragma unroll
                for (int r = 0; r < 16; ++r) { s0[r] -= dl; s1[r] -= dl; }
                if (!first) { const float f = __builtin_amdgcn_exp2f(-dl); lsum *= f;
#pragma unroll
                    for (int r = 0; r < 16; ++r) { o[0][r] *= f; o[1][r] *= f; } }
                first = false;
            }
            float ps = 0.f;
#pragma unroll
            for (int r = 0; r < 16; ++r) { s0[r] = __builtin_amdgcn_exp2f(s0[r]); s1[r] = __builtin_amdgcn_exp2f(s1[r]); ps += s0[r] + s1[r]; }
            lsum += ps;
#pragma unroll
            for (int k4 = 0; k4 < 4; ++k4) {
                bf16x8 pf;
                { unsigned w0, w1, w2, w3; const int rb = 8 * (k4 & 1);
                  if (k4 < 2) { w0 = cvtpk(s0[rb], s0[rb + 1]); w1 = cvtpk(s0[rb + 2], s0[rb + 3]); w2 = cvtpk(s0[rb + 4], s0[rb + 5]); w3 = cvtpk(s0[rb + 6], s0[rb + 7]); }
                  else { w0 = cvtpk(s1[rb], s1[rb + 1]); w1 = cvtpk(s1[rb + 2], s1[rb + 3]); w2 = cvtpk(s1[rb + 4], s1[rb + 5]); w3 = cvtpk(s1[rb + 6], s1[rb + 7]); }
                  v4u w = {w0, w1, w2, w3}; pf = __builtin_bit_cast(bf16x8, w); }
#pragma unroll
                for (int d0 = 0; d0 < 2; ++d0) {
                    const s16x4 lo = vtr(vf + d0 * 4096 + k4 * 1024), hi4 = vtr(vf + d0 * 4096 + k4 * 1024 + 512);
                    const bf16x8 vfr = {lo[0], lo[1], lo[2], lo[3], hi4[0], hi4[1], hi4[2], hi4[3]};
                    o[d0] = __builtin_amdgcn_mfma_f32_32x32x16_bf16(vfr, pf, o[d0], 0, 0, 0); }
            }
        }
        slot = slot == 2 ? 0 : slot + 1;
    }
#undef DMA_TILE
    const float ltot = swapsum(lsum), inv = 1.f / ltot;
#pragma unroll
    for (int r = 0; r < 16; ++r) { o[0][r] *= inv; o[1][r] *= inv; }
    bf16* orow = MIX + (rowbase + qrow0 + r32) * DM + ocol + 4 * hi;
    if (MODE != 2) {
#pragma unroll
        for (int d0 = 0; d0 < 2; ++d0)
#pragma unroll
            for (int g4 = 0; g4 < 4; ++g4) { u32x2 w; w.x = cvtpk(o[d0][4 * g4], o[d0][4 * g4 + 1]); w.y = cvtpk(o[d0][4 * g4 + 2], o[d0][4 * g4 + 3]); *(u32x2*)(orow + 32 * d0 + 8 * g4) = w; }
        LDS_WAIT(); __builtin_amdgcn_s_barrier(); asm volatile("" ::: "memory");
    } else {
        LAS float* scr = (LAS float*)(lds + L_SCR) + (wid & 3) * 2048 + lane;
        if (wid >= 4) {
#pragma unroll
            for (int d0 = 0; d0 < 2; ++d0)
#pragma unroll
                for (int r = 0; r < 16; ++r) scr[(d0 * 16 + r) * 64] = o[d0][r];
        }
        LDS_WAIT(); __builtin_amdgcn_s_barrier(); asm volatile("" ::: "memory");
        if (wid < 4) {
            const float lam = par[0], gs = par[1]; float ss = 0.f;
#pragma unroll
            for (int d0 = 0; d0 < 2; ++d0)
#pragma unroll
                for (int r = 0; r < 16; ++r) { const float d = o[d0][r] - lam * scr[(d0 * 16 + r) * 64]; o[d0][r] = d; ss += d * d; }
            ss = swapsum(ss);
            const float rs = gs / sqrtf(ss * (1.f / 64.f) + LN_EPS);
#pragma unroll
            for (int d0 = 0; d0 < 2; ++d0)
#pragma unroll
                for (int g4 = 0; g4 < 4; ++g4) { const int dv = 32 * d0 + 8 * g4 + 4 * hi; float v[4];
#pragma unroll
                    for (int j = 0; j < 4; ++j) v[j] = o[d0][4 * g4 + j] * rs * par[16 + dv + j];
                    u32x2 w; w.x = cvtpk(v[0], v[1]); w.y = cvtpk(v[2], v[3]); *(u32x2*)(orow + 32 * d0 + 8 * g4) = w; }
        }
        LDS_WAIT(); __builtin_amdgcn_s_barrier(); asm volatile("" ::: "memory");
    }
}
}

struct Args { const float* in[17]; float* out; unsigned char* ws; int ph_lo, ph_hi; int coop; int pad; };
constexpr int LDS_BYTES = 147456;
constexpr int N_PHASES = 1 + 7 * DEPTH;

__device__ __forceinline__ float wave_sum(float v) {
#pragma unroll
    for (int o = 1; o < 64; o <<= 1) v += __shfl_xor(v, o);
    return v;
}
__device__ __forceinline__ void transpose_item(const float* W, int K, int N, bf16* WT, LAS float* scr, int item, int lane) {
    const int nblk = N / 32, kb = item / nblk, nb = item % nblk, k0 = 64 * kb, n0 = 32 * nb;
#pragma unroll 8
    for (int i = 0; i < 32; ++i) { const int kk = 2 * i + (lane >> 5); scr[kk * 33 + (lane & 31)] = W[(size_t)(k0 + kk) * N + n0 + (lane & 31)]; }
    LDS_WAIT(); asm volatile("" ::: "memory");
    const int c = lane & 7;
#pragma unroll
    for (int j = 0; j < 4; ++j) { const int n = (lane >> 3) + 8 * j; const LAS float* s = scr + (8 * c) * 33 + n;
        v4u o; o.x = pk2(s[0 * 33], s[1 * 33]); o.y = pk2(s[2 * 33], s[3 * 33]); o.z = pk2(s[4 * 33], s[5 * 33]); o.w = pk2(s[6 * 33], s[7 * 33]);
        *(v4u*)(WT + (size_t)(n0 + n) * K + k0 + 8 * c) = o; }
    LDS_WAIT(); asm volatile("" ::: "memory");
}
__device__ __forceinline__ void ln_row(const float* xrow, const float* g, const float* bta, float* orow, bf16* brow, int lane) {
    const f32x4* xr = (const f32x4*)xrow + lane;
    f32x4 v[4]; float s = 0.f;
#pragma unroll
    for (int j = 0; j < 4; ++j) { v[j] = xr[64 * j]; s += (v[j].x + v[j].y) + (v[j].z + v[j].w); }
    const float mean = wave_sum(s) * (1.f / DM); float s2 = 0.f;
#pragma unroll
    for (int j = 0; j < 4; ++j) { v[j] = v[j] - mean; s2 += (v[j].x * v[j].x + v[j].y * v[j].y) + (v[j].z * v[j].z + v[j].w * v[j].w); }
    const float rstd = 1.f / sqrtf(wave_sum(s2) * (1.f / DM) + LN_EPS);
    f32x4* o4 = (f32x4*)orow + lane; unsigned long long* o8 = (unsigned long long*)brow + lane;
#pragma unroll
    for (int j = 0; j < 4; ++j) { const f32x4 gg = ((const f32x4*)g)[lane + 64 * j], bb = ((const f32x4*)bta)[lane + 64 * j];
        const f32x4 y = v[j] * rstd * gg + bb; o4[64 * j] = y;
        o8[64 * j] = (unsigned long long)pk2(y.x, y.y) | ((unsigned long long)pk2(y.z, y.w) << 32); }
}

__global__ void __launch_bounds__(NWAVES * 64, 2) mega_fwd(Args args) {
    extern __shared__ __attribute__((aligned(16))) unsigned char lds_raw[];
    LAS unsigned char* lds = (LAS unsigned char*)lds_raw;
    const int tid = threadIdx.x, lane = tid & 63, wave = __builtin_amdgcn_readfirstlane(tid >> 6);
    const int G = gridDim.x, bx = blockIdx.x; const int vcu = (G % 8 == 0) ? (bx % 8) * (G / 8) + bx / 8 : bx;
    typedef const __attribute__((address_space(4))) Args* kargp_t;
    kargp_t ap = (kargp_t)__builtin_amdgcn_kernarg_segment_ptr();
#define FRESH() asm volatile("" : "+s"(ap))
#define WSP(T, off) ((T*)(ap->ws + (off)))
    const float alpha = 1.4142135623730951f;
    const int gw = vcu * NWAVES + wave, NGW = G * NWAVES;
    const int lo = ap->ph_lo, hi = ap->ph_hi; const bool coop = ap->coop != 0;
#define IN(k) (lo <= (k) && (k) < hi)
#define SEAM(k) do { if (IN(k) && IN((k) + 1) && coop) cg::this_grid().sync(); } while (0)
    if (IN(0)) {
        FRESH(); const float* x_in = ap->in[0]; const float* ln_in_g = ap->in[1]; const float* ln_in_b = ap->in[2];
        const float* w_in = ap->in[4]; const float* w_out = ap->in[5]; const float* w_ff1 = ap->in[13]; const float* w_ff2 = ap->in[14];
        bf16* WIN = WSP(bf16, WS_WIN); bf16* WOUT = WSP(bf16, WS_WOUT); bf16* WFF1 = WSP(bf16, WS_WFF1); bf16* WFF2 = WSP(bf16, WS_WFF2); float* X = WSP(float, WS_X); bf16* XN = WSP(bf16, WS_XN);
        LAS float* scr = (LAS float*)(lds + wave * 16384);
        constexpr int I_IN = (DM / 64) * (NPROJ / 32), I_OUT = (DM / 64) * (DM / 32), I_F1 = (DM / 64) * (FF / 32), I_F2 = (FF / 64) * (DM / 32), I_L = I_IN + I_OUT + I_F1 + I_F2;
        for (int it = gw; it < DEPTH * I_L; it += NGW) {
            const int l = it / I_L; int r = it % I_L;
            if (r < I_IN) { transpose_item(w_in + (size_t)l * DM * NPROJ, DM, NPROJ, WIN + (size_t)l * DM * NPROJ, scr, r, lane); continue; } r -= I_IN;
            if (r < I_OUT) { transpose_item(w_out + (size_t)l * DM * DM, DM, DM, WOUT + (size_t)l * DM * DM, scr, r, lane); continue; } r -= I_OUT;
            if (r < I_F1) { transpose_item(w_ff1 + (size_t)l * DM * FF, DM, FF, WFF1 + (size_t)l * DM * FF, scr, r, lane); continue; } r -= I_F1;
            transpose_item(w_ff2 + (size_t)l * DM * FF, FF, DM, WFF2 + (size_t)l * DM * FF, scr, r, lane);
        }
        for (int m = gw; m < MTOK; m += NGW) ln_row(x_in + (size_t)m * DM, ln_in_g, ln_in_b, X + (size_t)m * DM, XN + (size_t)m * DM, lane);
    }
    SEAM(0);
#pragma unroll
    for (int l = 0; l < DEPTH; ++l) {
        const int p0 = 1 + 7 * l;
        if (IN(p0)) {
            FRESH(); pg8::Gemm g{WSP(bf16, WS_XN), WSP(bf16, WS_WIN) + (size_t)l * DM * NPROJ, MTOK, NPROJ, DM}; pg8::StaticOrder S; S.init(MTOK, NPROJ, G, bx);
            pg8::EpiBf<0> E{WSP(bf16, WS_PROJ), NPROJ, 0.125f * LOG2E, 0.17677669529663687f * LOG2E};
            pg8::gemm_phase<pg8::EpiBf<0>, pg8::StaticOrder, true, true>(lds, g, S, E);
        }
        SEAM(p0);
        if (IN(p0 + 1)) {
            FRESH(); att::build_tables((LAS char*)lds, ap->in[3], ap->in[6] + (size_t)l * 4 * 15 * 31, ap->in[7] + l * 8, ap->in[8] + l * 64, ap->in[9] + l * 64, ap->in[10] + l * 64, l);
            const bf16* PROJ = WSP(bf16, WS_PROJ); bf16* MIX = WSP(bf16, WS_MIX);
            if (G == 256) {
                for (int i = 0; i < 4; ++i) att::attn_unit<2>((LAS char*)lds, PROJ, MIX, (vcu >> 4) >> 2, (vcu >> 4) & 3, 4 * (vcu & 15) + i);
                for (int i = 0; i < 4; ++i) att::attn_unit<1>((LAS char*)lds, PROJ, MIX, (vcu >> 5) >> 1, (vcu >> 5) & 1, 4 * (vcu & 31) + i);
                for (int i = 0; i < 2; ++i) att::attn_unit<0>((LAS char*)lds, PROJ, MIX, (vcu >> 4) >> 2, (vcu >> 4) & 3, 2 * (vcu & 15) + i);
            }
        }
        SEAM(p0 + 1);
        if (IN(p0 + 2)) {
            FRESH(); pg8::Gemm g{WSP(bf16, WS_MIX), WSP(bf16, WS_WOUT) + (size_t)l * DM * DM, MTOK, DM, DM}; pg8::StaticOrder S; S.init(MTOK, DM, G, bx);
            pg8::EpiResid E{WSP(float, WS_X), ap->out, DM, alpha};
            pg8::gemm_phase<pg8::EpiResid, pg8::StaticOrder, true, true>(lds, g, S, E);
        }
        SEAM(p0 + 2);
        if (IN(p0 + 3)) {
            FRESH(); const float* Y = ap->out; const float* gg = ap->in[11] + l * DM; const float* bb = ap->in[12] + l * DM; float* X = WSP(float, WS_X); bf16* XN = WSP(bf16, WS_XN);
            for (int m = gw; m < MTOK; m += NGW) ln_row(Y + (size_t)m * DM, gg, bb, X + (size_t)m * DM, XN + (size_t)m * DM, lane);
        }
        SEAM(p0 + 3);
        if (IN(p0 + 4)) {
            FRESH(); pg8::Gemm g{WSP(bf16, WS_XN), WSP(bf16, WS_WFF1) + (size_t)l * DM * FF, MTOK, FF, DM}; pg8::StaticOrder S; S.init(MTOK, FF, G, bx);
            pg8::EpiBf<1> E{WSP(bf16, WS_H), FF, 1.f, 1.f};
            pg8::gemm_phase<pg8::EpiBf<1>, pg8::StaticOrder, true, true>(lds, g, S, E);
        }
        SEAM(p0 + 4);
        if (IN(p0 + 5)) {
            FRESH(); pg8::Gemm g{WSP(bf16, WS_H), WSP(bf16, WS_WFF2) + (size_t)l * DM * FF, MTOK, DM, FF}; pg8::StaticOrder S; S.init(MTOK, DM, G, bx);
            pg8::EpiResid E{WSP(float, WS_X), ap->out, DM, alpha};
            pg8::gemm_phase<pg8::EpiResid, pg8::StaticOrder, true, true>(lds, g, S, E);
        }
        SEAM(p0 + 5);
        if (IN(p0 + 6)) {
            FRESH(); float* Y = ap->out; const float* gg = ap->in[15] + l * DM; const float* bb = ap->in[16] + l * DM; bf16* XN = WSP(bf16, WS_XN);
            float* dst = (l == DEPTH - 1) ? Y : WSP(float, WS_X);
            for (int m = gw; m < MTOK; m += NGW) ln_row(Y + (size_t)m * DM, gg, bb, dst + (size_t)m * DM, XN + (size_t)m * DM, lane);
        }
        SEAM(p0 + 6);
    }
#undef IN
#undef SEAM
}

#ifndef MK_N_LAUNCHES
#define MK_N_LAUNCHES 1
#endif
extern "C" void kernel_launch(void* const* d_in, const int* in_sizes, int n_in, void* d_out, int out_size, void* d_ws, size_t ws_size, hipStream_t stream) {
    static int grid = 0;
    if (grid == 0) {
        if (n_in != 17 || in_sizes[0] != MTOK * DM || out_size != MTOK * DM || ws_size < WS_END) { fprintf(stderr, "kernel_launch: unexpected shapes (n_in %d, in0 %d, out %d, ws %zu); nothing launched\n", n_in, n_in > 0 ? in_sizes[0] : -1, out_size, ws_size); grid = -1; return; }
        int dev = 0, cus = 0, per_cu = 0;
        if (hipGetDevice(&dev) != hipSuccess || hipDeviceGetAttribute(&cus, hipDeviceAttributeMultiprocessorCount, dev) != hipSuccess) { grid = -1; return; }
        if (hipFuncSetAttribute((const void*)mega_fwd, hipFuncAttributeMaxDynamicSharedMemorySize, LDS_BYTES) != hipSuccess) { fprintf(stderr, "kernel_launch: hipFuncSetAttribute failed\n"); grid = -1; return; }
        if (hipOccupancyMaxActiveBlocksPerMultiprocessor(&per_cu, (const void*)mega_fwd, NWAVES * 64, LDS_BYTES) != hipSuccess || per_cu < 1) { fprintf(stderr, "kernel_launch: occupancy query says %d blocks per CU\n", per_cu); (void)hipGetLastError(); grid = -1; return; }
        grid = cus;
        if (grid != 256) fprintf(stderr, "kernel_launch: %d CUs (the attention phase is dealt for 256 workgroups)\n", grid);
    }
    if (grid < 0) return;
    Args a{};
    for (int i = 0; i < 17; ++i) a.in[i] = (const float*)d_in[i];
    a.out = (float*)d_out; a.ws = (unsigned char*)d_ws;
#if MK_N_LAUNCHES == 1
    a.ph_lo = 0; a.ph_hi = N_PHASES; a.coop = 1;
    void* kargs[] = {&a};
    hipError_t e = hipLaunchCooperativeKernel((const void*)mega_fwd, dim3(grid), dim3(NWAVES * 64), kargs, LDS_BYTES, stream);
    if (e != hipSuccess) fprintf(stderr, "kernel_launch: cooperative launch failed: %s (grid %d)\n", hipGetErrorString(e), grid);
#else
    for (int ph = 0; ph < N_PHASES; ++ph) {
        a.ph_lo = ph; a.ph_hi = ph + 1; a.coop = 0;
        hipLaunchKernelGGL(mega_fwd, dim3(grid), dim3(NWAVES * 64), LDS_BYTES, stream, a);
    }
#endif
}
```

```cpp
#include <hip/hip_runtime.h>
#include <hip/hip_cooperative_groups.h>
#include <cstdio>
#include <cstdint>
namespace cg = cooperative_groups;
namespace pg8 {
#define PG8_LAS __attribute__((address_space(3)))
typedef unsigned short bf16_t;
typedef short bf16x8 __attribute__((ext_vector_type(8)));
typedef float f32x4 __attribute__((ext_vector_type(4)));
typedef unsigned u32x4 __attribute__((ext_vector_type(4)));
constexpr int BM = 256, BK = 64, HALF = 128, HTB = HALF * BK * 2  , STAGE_BYTES = 8 * HTB, NXCD = 8, WGM = 8;

__host__ __device__ __forceinline__ int lds_byte(int r, int c) { const int st = (r >> 4) * 2 + (c >> 5), rr = r & 15, cc = c & 31, ob = rr * 64 + cc * 2; return st * 1024 + (ob ^ (((ob >> 9) & 1) << 5)); }
__host__ __device__ __forceinline__ void stage_rc(int b, int& R, int& C) { const int st = b / 1024, sb = b % 1024, swz = sb ^ (((sb >> 9) & 1) << 5); R = (st >> 1) * 16 + swz / 64; C = (st & 1) * 32 + (swz % 64) / 2; }
__host__ __device__ __forceinline__ int perm32(int rho) { const int n = rho >> 4, i = rho & 15; return 8 * (i >> 2) + 4 * n + (i & 3); }

struct Unit { int pm, pn; };
struct Gemm { const bf16_t* A; const bf16_t* Bt; int M, N, K; };

struct StaticOrder {
    int nM, nN, nwg, G, c;
    __host__ __device__ void init(int M, int N, int G_, int c_) { nM = M / BM; nN = N / BM; nwg = nM * nN; G = G_; c = c_; }
    __host__ __device__ bool next(int i, Unit& u) const {
        const long L = (long)i * G + c; if (L >= nwg) return false;
        int wgid = (int)L; { const int q = nwg / NXCD, r = nwg % NXCD, xcd = wgid % NXCD, off = wgid / NXCD; wgid = (xcd < r ? xcd * (q + 1) : r * (q + 1) + (xcd - r) * q) + off; }
        const int nig = WGM * nN, gid = wgid / nig, fm = gid * WGM, gsz = (nM - fm) < WGM ? (nM - fm) : WGM;
        u.pm = fm + ((wgid % nig) % gsz); u.pn = (wgid % nig) / gsz; return true;
    }
    __device__ __forceinline__ void a_ready(const Unit&) const {}
    __device__ __forceinline__ void done(const Unit&) const {}
};

__device__ __forceinline__ unsigned cvt_pk_bf16(float lo, float hi) { unsigned r; asm volatile("v_cvt_pk_bf16_f32 %0, %1, %2" : "=v"(r) : "v"(lo), "v"(hi)); return r; }
typedef float f32x2 __attribute__((ext_vector_type(2)));
typedef unsigned u32x2 __attribute__((ext_vector_type(2)));
template <int MODE> struct EpiBf {
    static constexpr bool PERM = true, AFTER_DRAIN = false;
    bf16_t* O; int ldc; float sA, sC;
    __device__ __forceinline__ void operator()(const f32x4 (&acc)[2][2][4][2], const Unit& u, int wr, int wc, int fr, int fq) const {
        const int row0 = u.pm * BM + wr * 64 + fr, col0 = u.pn * BM + wc * 32 + 8 * fq;
        float sc = 1.f;
        if (MODE == 0) { const int pn = u.pn; sc = (pn == 0 || pn == 3 || pn == 4) ? sA : (pn == 6 ? sC : 1.f); }
#pragma unroll
        for (int ai = 0; ai < 2; ++ai)
#pragma unroll
            for (int m = 0; m < 4; ++m) { bf16_t* rowp = O + (size_t)(row0 + ai * HALF + m * 16) * ldc + col0;
#pragma unroll
                for (int bj = 0; bj < 2; ++bj) { f32x4 v0 = acc[ai][bj][m][0], v1 = acc[ai][bj][m][1];
                    if (MODE == 0) { v0 = v0 * sc; v1 = v1 * sc; }
                    else { v0 = __builtin_elementwise_max(v0, (f32x4){0.f, 0.f, 0.f, 0.f}); v1 = __builtin_elementwise_max(v1, (f32x4){0.f, 0.f, 0.f, 0.f}); v0 = v0 * v0; v1 = v1 * v1; }
                    u32x4 w; w.x = cvt_pk_bf16(v0[0], v0[1]); w.y = cvt_pk_bf16(v0[2], v0[3]); w.z = cvt_pk_bf16(v1[0], v1[1]); w.w = cvt_pk_bf16(v1[2], v1[3]);
                    *(u32x4*)(rowp + bj * HALF) = w; } }
    }
};
struct EpiResid {
    static constexpr bool PERM = false, AFTER_DRAIN = false;
    const float* X; float* Y; int ldc; float alpha;
    __device__ __forceinline__ void operator()(const f32x4 (&acc)[2][2][4][2], const Unit& u, int wr, int wc, int fr, int fq) const {
        const int row0 = u.pm * BM + wr * 64 + fr, col0 = u.pn * BM + wc * 32 + 4 * fq;
#pragma unroll
        for (int ai = 0; ai < 2; ++ai)
#pragma unroll
            for (int m = 0; m < 4; ++m) { const size_t off = (size_t)(row0 + ai * HALF + m * 16) * ldc + col0;
#pragma unroll
                for (int bj = 0; bj < 2; ++bj)
#pragma unroll
                    for (int n = 0; n < 2; ++n) { const f32x4 x = *(const f32x4*)(X + off + bj * HALF + n * 16); *(f32x4*)(Y + off + bj * HALF + n * 16) = x * alpha + acc[ai][bj][m][n]; }
                asm volatile("" ::: "memory"); }
    }
};
template <class Epi, class Sched, bool ALIGN_EPI = false, bool SP2 = false>
__device__ __forceinline__ void gemm_phase(PG8_LAS unsigned char* lds, const Gemm g, const Sched& S, const Epi& E) {
    int tid_ = threadIdx.x; asm volatile("" : "+v"(tid_));
    const int tid = tid_, wid = __builtin_amdgcn_readfirstlane(tid >> 6), lane = tid & 63, wr = wid >> 2, wc = wid & 3, fr = lane & 15, fq = lane >> 4;
    const int K = g.K, nt = K / BK;
    unsigned voffA[2], voffB[2];
#pragma unroll
    for (int i = 0; i < 2; ++i) { int R, C; stage_rc(tid * 16 + i * 8192, R, C); const int Rb = Epi::PERM ? ((R & ~31) + perm32(R & 31)) : R;
        voffA[i] = (unsigned)(R * K + C) * 2u; voffB[i] = (unsigned)(Rb * K + C) * 2u; }
    const size_t kstep = (size_t)(BK * 2);
    const size_t hstep = (size_t)HALF * K * 2;
    const size_t tstep = 2 * hstep;
    const unsigned ldsw = (unsigned)wid * 1024u;
    const int aoff = lds_byte(wr * 64 + fr, fq * 8), boff = lds_byte(wc * 32 + fr, fq * 8);
#define PG8_SA(b, h) (((b) * 2 + (h)) * HTB)
#define PG8_SB(b, h) ((4 + (b) * 2 + (h)) * HTB)
#define PG8_STAGE(bufoff, gbase, voff) do { _Pragma("unroll") for (int _i = 0; _i < 2; ++_i) \
        __builtin_amdgcn_global_load_lds((const unsigned*)((const char*)(gbase) + (voff)[_i]), (PG8_LAS unsigned*)(lds + (bufoff) + ldsw + _i * 8192), 16, 0, 0); } while (0)
#define PG8_LDA(dst, b, h) do { _Pragma("unroll") for (int m = 0; m < 4; ++m) _Pragma("unroll") for (int k = 0; k < 2; ++k) dst[m][k] = *(const PG8_LAS bf16x8*)(lds + PG8_SA(b, h) + aoff + m * 2048 + k * 1024); } while (0)
#define PG8_LDB(dst, b, h) do { _Pragma("unroll") for (int n = 0; n < 2; ++n) _Pragma("unroll") for (int k = 0; k < 2; ++k) dst[n][k] = *(const PG8_LAS bf16x8*)(lds + PG8_SB(b, h) + boff + n * 2048 + k * 1024); } while (0)
#define PG8_MMA(ai, bj, At, Bt) do { __builtin_amdgcn_s_setprio(1); _Pragma("unroll") for (int m = 0; m < 4; ++m) _Pragma("unroll") for (int n = 0; n < 2; ++n) _Pragma("unroll") for (int k = 0; k < 2; ++k) \
        acc[ai][bj][m][n] = __builtin_amdgcn_mfma_f32_16x16x32_bf16(Bt[n][k], At[m][k], acc[ai][bj][m][n], 0, 0, 0); __builtin_amdgcn_s_setprio(0); } while (0)
#define PG8_WAIT_V(n) asm volatile("s_waitcnt vmcnt(" #n ")" ::: "memory")
#define PG8_WAIT_L(n) asm volatile("s_waitcnt lgkmcnt(" #n ")" ::: "memory")
#define PG8_BAR __builtin_amdgcn_s_barrier()
#define PG8_SCHED __builtin_amdgcn_sched_barrier(0)
    Unit cur, nxt; int ui = 0;
    if (!S.next(0, cur)) return;
    f32x4 acc[2][2][4][2];
#pragma unroll
    for (int a = 0; a < 2; ++a)
#pragma unroll
        for (int b = 0; b < 2; ++b)
#pragma unroll
            for (int m = 0; m < 4; ++m)
#pragma unroll
                for (int n = 0; n < 2; ++n) acc[a][b][m][n] = (f32x4){0.f, 0.f, 0.f, 0.f};
    bf16x8 At[4][2], B0[2][2], B1[2][2];
    const char* cA = (const char*)g.A + (size_t)cur.pm * tstep; const char* cB = (const char*)g.Bt + (size_t)cur.pn * tstep;
    S.a_ready(cur);
    if constexpr (SP2) {
        PG8_STAGE(PG8_SB(0, 0), cB, voffB); PG8_STAGE(PG8_SB(0, 1), cB + hstep, voffB); PG8_STAGE(PG8_SA(0, 0), cA, voffA); PG8_STAGE(PG8_SA(0, 1), cA + hstep, voffA);
        if (wr == 1) PG8_BAR;
        PG8_WAIT_V(2); PG8_BAR;
        PG8_STAGE(PG8_SB(1, 0), cB + kstep, voffB); PG8_STAGE(PG8_SA(1, 0), cA + kstep, voffA); PG8_STAGE(PG8_SB(1, 1), cB + hstep + kstep, voffB);
        PG8_WAIT_V(6); PG8_BAR;
    } else {
        PG8_STAGE(PG8_SB(0, 0), cB, voffB); PG8_STAGE(PG8_SA(0, 0), cA, voffA); PG8_STAGE(PG8_SB(0, 1), cB + hstep, voffB); PG8_STAGE(PG8_SA(0, 1), cA + hstep, voffA);
        if (wr == 1) PG8_BAR;
        PG8_WAIT_V(4); PG8_BAR;
        PG8_STAGE(PG8_SB(1, 0), cB + kstep, voffB); PG8_STAGE(PG8_SA(1, 0), cA + kstep, voffA); PG8_STAGE(PG8_SB(1, 1), cB + hstep + kstep, voffB);
        PG8_WAIT_V(6); PG8_BAR;
    }
    for (;;) {
        const bool has_next = S.next(ui + 1, nxt);
        const char* nA = has_next ? (const char*)g.A + (size_t)nxt.pm * tstep : cA; const char* nB = has_next ? (const char*)g.Bt + (size_t)nxt.pn * tstep : cB;
        for (int t = 0; t < nt; t += 2) {
            const bool last = (t == nt - 2);
            const char* a1 = cA + (size_t)(t + 1) * kstep;
            const char* a2 = last ? nA : cA + (size_t)(t + 2) * kstep; const char* b2 = last ? nB : cB + (size_t)(t + 2) * kstep;
            const char* a3 = a2 + kstep; const char* b3 = b2 + kstep;
            if (last && has_next) S.a_ready(nxt);
            if constexpr (SP2) {
            PG8_LDB(B0, 0, 0); PG8_LDB(B1, 0, 1); PG8_SCHED; PG8_LDA(At, 0, 0); PG8_STAGE(PG8_SA(1, 1), a1 + hstep, voffA);
            PG8_WAIT_V(8); PG8_WAIT_L(0); PG8_BAR; PG8_MMA(0, 0, At, B0); PG8_MMA(0, 1, At, B1); PG8_BAR; PG8_SCHED;
            PG8_LDA(At, 0, 1); PG8_STAGE(PG8_SB(0, 0), b2, voffB); PG8_STAGE(PG8_SB(0, 1), b2 + hstep, voffB); PG8_STAGE(PG8_SA(0, 0), a2, voffA);
            PG8_WAIT_V(8); PG8_WAIT_L(0); PG8_BAR; PG8_MMA(1, 0, At, B0); PG8_MMA(1, 1, At, B1); PG8_BAR; PG8_SCHED;
            PG8_LDB(B0, 1, 0); PG8_LDB(B1, 1, 1); PG8_SCHED; PG8_LDA(At, 1, 0); PG8_STAGE(PG8_SA(0, 1), a2 + hstep, voffA);
            PG8_WAIT_V(8); PG8_WAIT_L(0); PG8_BAR; PG8_MMA(0, 0, At, B0); PG8_MMA(0, 1, At, B1); PG8_BAR; PG8_SCHED;
            PG8_LDA(At, 1, 1); PG8_STAGE(PG8_SB(1, 0), b3, voffB); PG8_STAGE(PG8_SB(1, 1), b3 + hstep, voffB); PG8_STAGE(PG8_SA(1, 0), a3, voffA);
            PG8_WAIT_V(8); PG8_WAIT_L(0); PG8_BAR; PG8_MMA(1, 0, At, B0); PG8_MMA(1, 1, At, B1); PG8_BAR; PG8_SCHED;
            } else {
            PG8_LDB(B0, 0, 0); PG8_SCHED; PG8_LDA(At, 0, 0); PG8_STAGE(PG8_SA(1, 1), a1 + hstep, voffA);
            PG8_WAIT_L(8); PG8_BAR; PG8_WAIT_L(0); PG8_MMA(0, 0, At, B0); PG8_BAR; PG8_SCHED;
            PG8_LDB(B1, 0, 1); PG8_STAGE(PG8_SB(0, 0), b2, voffB);
            PG8_BAR; PG8_WAIT_L(0); PG8_MMA(0, 1, At, B1); PG8_BAR;
            PG8_LDA(At, 0, 1); PG8_STAGE(PG8_SA(0, 0), a2, voffA);
            PG8_BAR; PG8_WAIT_L(0); PG8_MMA(1, 0, At, B0); PG8_BAR; PG8_SCHED;
            PG8_STAGE(PG8_SB(0, 1), b2 + hstep, voffB);
            PG8_WAIT_V(6); PG8_BAR; PG8_MMA(1, 1, At, B1); PG8_BAR;
            PG8_LDB(B0, 1, 0); PG8_SCHED; PG8_LDA(At, 1, 0); PG8_STAGE(PG8_SA(0, 1), a2 + hstep, voffA);
            PG8_WAIT_L(8); PG8_BAR; PG8_WAIT_L(0); PG8_MMA(0, 0, At, B0); PG8_BAR; PG8_SCHED;
            PG8_LDB(B1, 1, 1); PG8_STAGE(PG8_SB(1, 0), b3, voffB);
            PG8_BAR; PG8_WAIT_L(0); PG8_MMA(0, 1, At, B1); PG8_BAR;
            PG8_LDA(At, 1, 1); PG8_STAGE(PG8_SA(1, 0), a3, voffA);
            PG8_BAR; PG8_WAIT_L(0); PG8_MMA(1, 0, At, B0); PG8_BAR; PG8_SCHED;
            PG8_STAGE(PG8_SB(1, 1), b3 + hstep, voffB);
            PG8_WAIT_V(6); PG8_BAR; PG8_MMA(1, 1, At, B1); PG8_BAR;
            }
        }
        if constexpr (ALIGN_EPI) { if (wr == 0) PG8_BAR; }
        if constexpr (!Epi::AFTER_DRAIN) { E(acc, cur, wr, wc, fr, fq); S.done(cur); }
        if (!has_next) break;
#pragma unroll
        for (int a = 0; a < 2; ++a)
#pragma unroll
            for (int b = 0; b < 2; ++b)
#pragma unroll
                for (int m = 0; m < 4; ++m)
#pragma unroll
                    for (int n = 0; n < 2; ++n) acc[a][b][m][n] = (f32x4){0.f, 0.f, 0.f, 0.f};
        cur = nxt; cA = nA; cB = nB; ++ui;
        if constexpr (ALIGN_EPI) { if (wr == 1) PG8_BAR; }
    }
    PG8_WAIT_V(0);
    if constexpr (!ALIGN_EPI) { if (wr == 0) PG8_BAR; }
    PG8_BAR;
    if constexpr (Epi::AFTER_DRAIN) { E.fused(acc, cur, wr, wc, fr, fq, lds, wid, lane); S.done(cur); }
#undef PG8_SA
#undef PG8_SB
#undef PG8_STAGE
#undef PG8_LDA
#undef PG8_LDB
#undef PG8_MMA
#undef PG8_WAIT_V
#undef PG8_WAIT_L
#undef PG8_BAR
#undef PG8_SCHED
}
}

constexpr int BATCH = 4, SEQ = 8192, DM = 1024, MTOK = BATCH * SEQ, NPROJ = 2304, FF = 4096, DEPTH = 2;
constexpr float LN_EPS = 1e-5f, LOG2E = 1.4426950408889634f;
constexpr int NWAVES = 8;
#define GAS __attribute__((address_space(1)))
#define LAS __attribute__((address_space(3)))
typedef unsigned short bf16;
typedef unsigned v4u __attribute__((ext_vector_type(4)));
typedef float f32x4 __attribute__((ext_vector_type(4)));
#define LDS_WAIT() asm volatile("s_waitcnt lgkmcnt(0)" ::: "memory")
#define VM_WAIT() asm volatile("s_waitcnt vmcnt(0)" ::: "memory")
__device__ __forceinline__ unsigned f2bf(float f) { unsigned u = __builtin_bit_cast(unsigned, f); return (u + 0x7fffu + ((u >> 16) & 1u)) >> 16; }
__device__ __forceinline__ unsigned pk2(float lo, float hi) { return f2bf(lo) | (f2bf(hi) << 16); }

constexpr size_t MiB = 1u << 20;
constexpr size_t WS_CTL = 0;
constexpr size_t WS_WIN = 1 * MiB;
constexpr size_t WS_WOUT = 10 * MiB;
constexpr size_t WS_WFF1 = 14 * MiB;
constexpr size_t WS_WFF2 = 30 * MiB;
constexpr size_t WS_X = 48 * MiB;
constexpr size_t WS_XN = 176 * MiB;
constexpr size_t WS_H = 240 * MiB;
constexpr size_t WS_PROJ = 240 * MiB;
constexpr size_t WS_MIX = 384 * MiB;
constexpr size_t WS_END = 496 * MiB;

namespace att {
typedef short bf16x8 __attribute__((ext_vector_type(8)));
typedef short s16x4 __attribute__((ext_vector_type(4)));
typedef float f32x16 __attribute__((ext_vector_type(16)));
typedef unsigned u32x2 __attribute__((ext_vector_type(2)));
constexpr int PITCH = NPROJ;
constexpr int SLOTB = 16384, NSLOT = 3;
constexpr int L_RING = 0, L_SCR = 49152, L_LUTB = 81920, L_LUTC = 94208, L_RPB = 98560, L_PAR = 106240, L_END = 106752;
constexpr int LUTB_W = 383, LUTC_W = 257;
constexpr float NEGBIG = -1e30f;
constexpr int THR = 6;
__device__ __forceinline__ int crow(int r, int hi) { return (r & 3) + 8 * (r >> 2) + 4 * hi; }
__device__ __forceinline__ void glds16(const void* gsrc, unsigned lds_dst) { unsigned keep;
    asm volatile("s_mov_b32 %0, m0\n\ts_mov_b32 m0, %2\n\ts_nop 0\n\tglobal_load_lds_dwordx4 %1, off\n\ts_mov_b32 m0, %0" : "=&s"(keep) : "v"(gsrc), "s"(lds_dst) : "memory"); }
typedef float f32x2_t __attribute__((ext_vector_type(2))); typedef __bf16 bf16x2_t __attribute__((ext_vector_type(2)));
__device__ __forceinline__ unsigned cvtpk(float lo, float hi) { f32x2_t v = {lo, hi}; bf16x2_t b = __builtin_convertvector(v, bf16x2_t); return __builtin_bit_cast(unsigned, b); }
typedef short v4i16_t __attribute__((ext_vector_type(4)));
__device__ __forceinline__ s16x4 vtr(const LAS char* p) { return __builtin_bit_cast(s16x4, __builtin_amdgcn_ds_read_tr16_b64_v4i16((LAS v4i16_t*)p)); }
__device__ __forceinline__ float swapmax(float m) { auto rr = __builtin_amdgcn_permlane32_swap(__float_as_uint(m), __float_as_uint(m), false, false); return fmaxf(__uint_as_float(rr[0]), __uint_as_float(rr[1])); }
__device__ __forceinline__ float swapsum(float m) { auto rr = __builtin_amdgcn_permlane32_swap(__float_as_uint(m), __float_as_uint(m), false, false); return __uint_as_float(rr[0]) + __uint_as_float(rr[1]); }
__device__ __forceinline__ int t5_bucket(int rel) {
    const int n = rel < 0 ? -rel : rel;
    const int b = n < 8 ? n : n < 12 ? 8 : n < 16 ? 9 : n < 23 ? 10 : n < 32 ? 11 : n < 46 ? 12 : n < 64 ? 13 : n < 91 ? 14 : 15;
    return b + (rel > 0 ? 16 : 0);
}
__device__ __forceinline__ void build_tables(LAS char* lds, const float* t5, const float* rpb, const float* sink, const float* lq, const float* lk, const float* g, int layer) {
    int tid = threadIdx.x; asm volatile("" : "+v"(tid));
    LAS float* lutB = (LAS float*)(lds + L_LUTB); LAS float* lutC = (LAS float*)(lds + L_LUTC); LAS float* rp = (LAS float*)(lds + L_RPB); LAS float* par = (LAS float*)(lds + L_PAR);
    for (int i = tid; i < 8 * LUTB_W; i += 512) { const int h = i / LUTB_W, rel = i % LUTB_W - 191; const int a = rel < 0 ? -rel : rel;
        lutB[i] = a <= 128 ? t5[t5_bucket(rel) * 12 + h] * LOG2E : NEGBIG; }
    for (int i = tid; i < 4 * LUTC_W; i += 512) { const int h = i / LUTC_W, rel = i % LUTC_W - 128; lutC[i] = t5[t5_bucket(rel) * 12 + 8 + h] * LOG2E; }
    for (int i = tid; i < 4 * 15 * 31; i += 512) rp[i] = rpb[i] * LOG2E;
    if (tid < 64) {
        const int l = tid; float p0 = 0.f, p1 = 0.f;
        if (l < 32) { p0 = lq[l] * lk[l]; p1 = lq[32 + l] * lk[32 + l]; }
#pragma unroll
        for (int o = 1; o < 64; o <<= 1) { p0 += __builtin_bit_cast(float, __builtin_amdgcn_ds_bpermute((l ^ o) << 2, __builtin_bit_cast(int, p0))); p1 += __builtin_bit_cast(float, __builtin_amdgcn_ds_bpermute((l ^ o) << 2, __builtin_bit_cast(int, p1))); }
        const float lam_init = layer == 0 ? 0.2f : 0.35550906759097f;
        if (l == 0) { par[0] = expf(p0) - expf(p1) + lam_init; par[1] = 1.f - lam_init; }
        if (l < 8) par[8 + l] = sink[l] * LOG2E;
        par[16 + l] = g[l];
    }
    LDS_WAIT(); __syncthreads();
}

template <int MODE> __device__ __forceinline__ void attn_unit(LAS char* lds, const bf16* PROJ, bf16* MIX, int b, int hh, int blk) {
    int tid_ = threadIdx.x; asm volatile("" : "+v"(tid_));
    const int tid = tid_, lane = tid & 63, r32 = lane & 31, hi = lane >> 5; const int wid = __builtin_amdgcn_readfirstlane(tid >> 6);
    constexpr int KS = (MODE == 2) ? 2 : 4;
    const long rowbase = (long)b * SEQ;
    int qrow0, qcol, kcol, vcol, ocol, t0, t1, kc0 = 0, myl = 0, hq = hh;
    if (MODE == 0) { const int r = 4 * blk + (wid >> 1); qrow0 = 64 * r + 32 * (wid & 1); qcol = hh * 64; kcol = 256 + hh * 64; vcol = 512 + hh * 64; ocol = hh * 64;
        const int lo = min(max(4 * blk - 4, 0), 120), hi_ = min(max(4 * blk - 1, 0), 120); t0 = lo; t1 = hi_ + 8; myl = min(max(r - 4, 0), 120); }
    else if (MODE == 1) { hq = hh * 4 + (wid >> 1); qrow0 = 64 * blk + 32 * (wid & 1); qcol = 768 + hq * 64; kcol = 1280 + hh * 64; vcol = 1408 + hh * 64; ocol = 256 + hq * 64;
        t0 = max(0, blk - 2); t1 = min(SEQ / 64, blk + 3); }
    else { const int m = wid >> 2; qrow0 = 128 * blk + 32 * (wid & 3); qcol = 1536 + hh * 64 + 32 * m; kcol = 1792 + hh * 64; vcol = 2048 + hh * 64; ocol = 768 + hh * 64; kc0 = 4 * m; t0 = 0; t1 = SEQ / 64; }
    const LAS float* lutB = (const LAS float*)(lds + L_LUTB); const LAS float* lutC = (const LAS float*)(lds + L_LUTC); const LAS float* rp = (const LAS float*)(lds + L_RPB); const LAS float* par = (const LAS float*)(lds + L_PAR);
    const bf16* ksrc = PROJ + (rowbase + lane) * PITCH + kcol + wid * 8;
    const bf16* vsrc = PROJ + (rowbase + 16 * (wid & 3) + (lane >> 2)) * PITCH + vcol + (wid >> 2) * 32 + (lane & 3) * 8;
    const unsigned ring0 = (unsigned)(uintptr_t)(lds + L_RING);
    const unsigned kdst = ring0 + wid * 1024, vdst = ring0 + 8192 + wid * 1024;
#define DMA_TILE(t, slot) do { glds16(ksrc + (long)(t) * 64 * PITCH, (unsigned)__builtin_amdgcn_readfirstlane(kdst + (slot) * SLOTB)); glds16(vsrc + (long)(t) * 64 * PITCH, (unsigned)__builtin_amdgcn_readfirstlane(vdst + (slot) * SLOTB)); } while (0)
    bf16x8 qr[KS];
    { const bf16* qp = PROJ + (rowbase + qrow0 + r32) * PITCH + qcol + 8 * hi;
#pragma unroll
      for (int ks = 0; ks < KS; ++ks) qr[ks] = *(const bf16x8*)(qp + 16 * ks); }
    DMA_TILE(t0, 0); if (t0 + 1 < t1) DMA_TILE(t0 + 1, 1);
    float mhat = 0.f, lsum = 0.f; f32x16 o[2]; o[0] = f32x16{}; o[1] = f32x16{};
    bool first = true;
    if (MODE == 1) { mhat = par[8 + hq]; lsum = hi == 0 ? 1.f : 0.f; first = false; }
    const LAS char* kfrag0 = lds + L_RING + (kc0 + hi) * 1024 + r32 * 16;
    const LAS char* vfrag0 = lds + L_RING + 8192 + ((lane >> 4) & 1) * 32 + (lane & 3) * 8 + (4 * hi + ((lane & 15) >> 2)) * 64;
    float cL = 0.f, cR = 0.f;
    if (MODE == 2) { cL = lutC[hh * LUTC_W + 0]; cR = lutC[hh * LUTC_W + 256]; }
    int slot = 0;
    for (int t = t0; t < t1; ++t) {
        if (t + 1 < t1) asm volatile("s_waitcnt vmcnt(2)" ::: "memory"); else asm volatile("s_waitcnt vmcnt(0)" ::: "memory");
        __builtin_amdgcn_s_barrier(); asm volatile("" ::: "memory");
        if (t + 2 < t1) { const int s2 = slot == 0 ? 2 : slot - 1; DMA_TILE(t + 2, s2); }
        const bool mine = (MODE != 0) || (t >= myl && t < myl + 8);
        if (mine) {
            const LAS char* kf = kfrag0 + slot * SLOTB; const LAS char* vf = vfrag0 + slot * SLOTB;
            f32x16 s0, s1;
            if (MODE == 2) {
                const int k0 = 64 * t, dlt = k0 - qrow0;
                if (dlt <= -154 || dlt >= 122) { const float c = (dlt < 0 ? cL : cR) - mhat;
#pragma unroll
                    for (int r = 0; r < 16; ++r) { s0[r] = c; s1[r] = c; } }
                else { const int lb = dlt - r32 + 4 * hi + 128;
#pragma unroll
                    for (int r = 0; r < 16; ++r) { const int c_r = (r & 3) + 8 * (r >> 2);
                        s0[r] = lutC[hh * LUTC_W + min(max(lb + c_r, 0), 256)] - mhat; s1[r] = lutC[hh * LUTC_W + min(max(lb + c_r + 32, 0), 256)] - mhat; } }
            } else if (MODE == 1) {
                const int lb = 64 * (t - blk) - 32 * (wid & 1) - r32 + 4 * hi + 191;
#pragma unroll
                for (int r = 0; r < 16; ++r) { const int c_r = (r & 3) + 8 * (r >> 2); s0[r] = lutB[hq * LUTB_W + lb + c_r] - mhat; s1[r] = lutB[hq * LUTB_W + lb + c_r + 32] - mhat; }
            } else {
                const int r_ = 4 * blk + (wid >> 1), dr = t - r_; const int cq = 32 * (wid & 1) + r32, cs = min(max(cq - 8, 0), 48);
                const int tb = 4 * hi - cs, eq = 15 - (cq - cs); const LAS float* rrow = rp + (hh * 15 + dr + 7) * 31;
#pragma unroll
                for (int r = 0; r < 16; ++r) { const int c_r = (r & 3) + 8 * (r >> 2);
                    const int ta = tb + c_r, tb2 = ta + 32;
                    const float va = rrow[min(max(ta + eq, 0), 30)], vb = rrow[min(max(tb2 + eq, 0), 30)];
                    s0[r] = ((unsigned)ta < 16u) ? va - mhat : NEGBIG; s1[r] = ((unsigned)tb2 < 16u) ? vb - mhat : NEGBIG; }
            }
#pragma unroll
            for (int ks = 0; ks < KS; ++ks) {
                const bf16x8 a0 = *(const LAS bf16x8*)(kf + ks * 2048), a1 = *(const LAS bf16x8*)(kf + ks * 2048 + 512);
                s0 = __builtin_amdgcn_mfma_f32_32x32x16_bf16(a0, qr[ks], s0, 0, 0, 0); s1 = __builtin_amdgcn_mfma_f32_32x32x16_bf16(a1, qr[ks], s1, 0, 0, 0); }
            float rm = fmaxf(s0[0], s1[0]);
#pragma unroll
            for (int r = 1; r < 16; ++r) rm = fmaxf(fmaxf(rm, s0[r]), s1[r]);
            rm = swapmax(rm);
            if (first || __any(rm > (float)THR)) {
                const float dl = first ? rm : fmaxf(rm, 0.f); mhat += dl;
#pragma unroll
                for (int r = 0; r < 16; ++r) { s0[r] -= dl; s1[r] -= dl; }
                if (!first) { const float f = __builtin_amdgcn_exp2f(-dl); lsum *= f;
#pragma unroll
                    for (int r = 0; r < 16; ++r) { o[0][r] *= f; o[1][r] *= f; } }
                first = false;
            }
            float ps = 0.f;
#pragma unroll
            for (int r = 0; r < 16; ++r) { s0[r] = __builtin_amdgcn_exp2f(s0[r]); s1[r] = __builtin_amdgcn_exp2f(s1[r]); ps += s0[r] + s1[r]; }
            lsum += ps;
#pragma unroll
            for (int k4 = 0; k4 < 4; ++k4) {
                bf16x8 pf;
                { unsigned w0, w1, w2, w3; const int rb = 8 * (k4 & 1);
                  if (k4 < 2) { w0 = cvtpk(s0[rb], s0[rb + 1]); w1 = cvtpk(s0[rb + 2], s0[rb + 3]); w2 = cvtpk(s0[rb + 4], s0[rb + 5]); w3 = cvtpk(s0[rb + 6], s0[rb + 7]); }
                  else { w0 = cvtpk(s1[rb], s1[rb + 1]); w1 = cvtpk(s1[rb + 2], s1[rb + 3]); w2 = cvtpk(s1[rb + 4], s1[rb + 5]); w3 = cvtpk(s1[rb + 6], s1[rb + 7]); }
                  v4u w = {w0, w1, w2, w3}; pf = __builtin_bit_cast(bf16x8, w); }
#pragma unroll
                for (int d0 = 0; d0 < 2; ++d0) {
                    const s16x4 lo = vtr(vf + d0 * 4096 + k4 * 1024), hi4 = vtr(vf + d0 * 4096 + k4 * 1024 + 512);
                    const bf16x8 vfr = {lo[0], lo[1], lo[2], lo[3], hi4[0], hi4[1], hi4[2], hi4[3]};
                    o[d0] = __builtin_amdgcn_mfma_f32_32x32x16_bf16(vfr, pf, o[d0], 0, 0, 0); }
            }
        }
        slot = slot == 2 ? 0 : slot + 1;
    }
#undef DMA_TILE
    const float ltot = swapsum(lsum), inv = 1.f / ltot;
#pragma unroll
    for (int r = 0; r < 16; ++r) { o[0][r] *= inv; o[1][r] *= inv; }
    bf16* orow = MIX + (rowbase + qrow0 + r32) * DM + ocol + 4 * hi;
    if (MODE != 2) {
#pragma unroll
        for (int d0 = 0; d0 < 2; ++d0)
#pragma unroll
            for (int g4 = 0; g4 < 4; ++g4) { u32x2 w; w.x = cvtpk(o[d0][4 * g4], o[d0][4 * g4 + 1]); w.y = cvtpk(o[d0][4 * g4 + 2], o[d0][4 * g4 + 3]); *(u32x2*)(orow + 32 * d0 + 8 * g4) = w; }
        LDS_WAIT(); __builtin_amdgcn_s_barrier(); asm volatile("" ::: "memory");
    } else {
        LAS float* scr = (LAS float*)(lds + L_SCR) + (wid & 3) * 2048 + lane;
        if (wid >= 4) {
#pragma unroll
            for (int d0 = 0; d0 < 2; ++d0)
#pragma unroll
                for (int r = 0; r < 16; ++r) scr[(d0 * 16 + r) * 64] = o[d0][r];
        }
        LDS_WAIT(); __builtin_amdgcn_s_barrier(); asm volatile("" ::: "memory");
        if (wid < 4) {
            const float lam = par[0], gs = par[1]; float ss = 0.f;
#pragma unroll
            for (int d0 = 0; d0 < 2; ++d0)
#pragma unroll
                for (int r = 0; r < 16; ++r) { const float d = o[d0][r] - lam * scr[(d0 * 16 + r) * 64]; o[d0][r] = d; ss += d * d; }
            ss = swapsum(ss);
            const float rs = gs / sqrtf(ss * (1.f / 64.f) + LN_EPS);
#pragma unroll
            for (int d0 = 0; d0 < 2; ++d0)
#pragma unroll
                for (int g4 = 0; g4 < 4; ++g4) { const int dv = 32 * d0 + 8 * g4 + 4 * hi; float v[4];
#pragma unroll
                    for (int j = 0; j < 4; ++j) v[j] = o[d0][4 * g4 + j] * rs * par[16 + dv + j];
                    u32x2 w; w.x = cvtpk(v[0], v[1]); w.y = cvtpk(v[2], v[3]); *(u32x2*)(orow + 32 * d0 + 8 * g4) = w; }
        }
        LDS_WAIT(); __builtin_amdgcn_s_barrier(); asm volatile("" ::: "memory");
    }
}

#define SBAR() __builtin_amdgcn_sched_barrier(0)
#define WAIT_BAR(N) asm volatile("s_waitcnt vmcnt(" #N ") lgkmcnt(0)\n\ts_barrier" ::: "memory")
__device__ __forceinline__ void attn_unit_c(LAS char* lds, const bf16* PROJ, bf16* MIX, int b, int hh, int blk) {
    int tid_ = threadIdx.x; asm volatile("" : "+v"(tid_));
    const int tid = tid_, lane = tid & 63, r32 = lane & 31, hi = lane >> 5; const int wid = __builtin_amdgcn_readfirstlane(tid >> 6);
    constexpr int NT = SEQ / 64, KRB = 8192;
    const long rowbase = (long)b * SEQ;
    const int m = wid >> 2, qrow0 = 128 * blk + 32 * (wid & 3), qcol = 1536 + hh * 64 + 32 * m, kcol = 1792 + hh * 64, vcol = 2048 + hh * 64, ocol = 768 + hh * 64;
    const LAS float* lutC = (const LAS float*)(lds + L_LUTC) + hh * LUTC_W; const LAS float* par = (const LAS float*)(lds + L_PAR);
    const bf16* ksrc = PROJ + (rowbase + lane) * PITCH + kcol + wid * 8;
    const bf16* vsrc = PROJ + (rowbase + 16 * (wid & 3) + (lane >> 2)) * PITCH + vcol + (wid >> 2) * 32 + (lane & 3) * 8;
    const unsigned kr0 = (unsigned)(uintptr_t)(lds + L_RING), vr0 = kr0 + 3 * KRB;
    const unsigned kdst = kr0 + wid * 1024, vdst = vr0 + wid * 1024;
#define DMA_K(t, so) glds16(ksrc + (long)(t) * 64 * PITCH, (unsigned)__builtin_amdgcn_readfirstlane(kdst + (so)))
#define DMA_V(t, so) glds16(vsrc + (long)(t) * 64 * PITCH, (unsigned)__builtin_amdgcn_readfirstlane(vdst + (so)))
    bf16x8 qr[2];
    { const bf16* qp = PROJ + (rowbase + qrow0 + r32) * PITCH + qcol + 8 * hi; qr[0] = *(const bf16x8*)(qp); qr[1] = *(const bf16x8*)(qp + 16); }
    DMA_K(0, 0); DMA_V(0, 0); DMA_K(1, KRB); DMA_K(2, 2 * KRB);
    const LAS char* kp0 = lds + L_RING + (4 * m + hi) * 1024 + r32 * 16;
    const LAS char* vp0 = lds + L_RING + 3 * KRB + ((lane >> 4) & 1) * 32 + (lane & 3) * 8 + (4 * hi + ((lane & 15) >> 2)) * 64;
    const float cL = lutC[0], cR = lutC[256];
    float mhat = 0.f, cside; int side;
    f32x16 o[2]; o[0] = f32x16{}; o[1] = f32x16{}; f32x16 lacc = f32x16{};
    f32x16 cfar; bf16x8 kf[4];
    const bf16x8 ones = {0x3F80, 0x3F80, 0x3F80, 0x3F80, 0x3F80, 0x3F80, 0x3F80, 0x3F80};
#define SIDE_OF(t) ((64 * (t) - qrow0) <= -154 ? 0 : ((64 * (t) - qrow0) >= 122 ? 2 : 1))
#define SET_CFAR() do { const float c_ = cside - mhat; _Pragma("unroll") for (int r = 0; r < 16; ++r) cfar[r] = c_; asm volatile("" : "+v"(cfar)); } while (0)
#define KLOAD(so) do { kf[0] = *(const LAS bf16x8*)(kp0 + (so)); kf[1] = *(const LAS bf16x8*)(kp0 + (so) + 512); kf[2] = *(const LAS bf16x8*)(kp0 + (so) + 2048); kf[3] = *(const LAS bf16x8*)(kp0 + (so) + 2560); } while (0)
#define NEAR_BIAS(C0, C1, t) do { const int lb = 64 * (t) - qrow0 - r32 + 4 * hi + 128; \
        _Pragma("unroll") for (int r = 0; r < 16; ++r) { const int c_r = (r & 3) + 8 * (r >> 2); C0[r] += lutC[min(max(lb + c_r, 0), 256)]; C1[r] += lutC[min(max(lb + c_r + 32, 0), 256)]; } } while (0)
#define ROWMAX(C0, C1, rm) do { float a_ = fmaxf(C0[0], C1[0]), b_ = fmaxf(C0[1], C1[1]); \
        _Pragma("unroll") for (int r = 2; r < 16; r += 2) { a_ = fmaxf(fmaxf(a_, C0[r]), C1[r]); b_ = fmaxf(fmaxf(b_, C0[r + 1]), C1[r + 1]); } rm = swapmax(fmaxf(a_, b_)); } while (0)
    f32x16 pA0, pA1, pB0, pB1;
    WAIT_BAR(3);
    side = SIDE_OF(0); cside = side == 0 ? cL : (side == 2 ? cR : 0.f); SET_CFAR();
    KLOAD(0);
    pA0 = __builtin_amdgcn_mfma_f32_32x32x16_bf16(kf[0], qr[0], cfar, 0, 0, 0); pA1 = __builtin_amdgcn_mfma_f32_32x32x16_bf16(kf[1], qr[0], cfar, 0, 0, 0);
    pA0 = __builtin_amdgcn_mfma_f32_32x32x16_bf16(kf[2], qr[1], pA0, 0, 0, 0); pA1 = __builtin_amdgcn_mfma_f32_32x32x16_bf16(kf[3], qr[1], pA1, 0, 0, 0);
    if (side == 1) NEAR_BIAS(pA0, pA1, 0);
    { float rm; ROWMAX(pA0, pA1, rm); mhat = rm;
#pragma unroll
      for (int r = 0; r < 16; ++r) { pA0[r] = __builtin_amdgcn_exp2f(pA0[r] - rm); pA1[r] = __builtin_amdgcn_exp2f(pA1[r] - rm); }
      SET_CFAR(); }
    WAIT_BAR(0);
    DMA_K(3, 0); DMA_V(1, KRB);
    KLOAD(KRB);
    WAIT_BAR(2);
    int sl_prev = 0, sl_cur = KRB, sl_next = 2 * KRB;
#define ROT() do { sl_prev = sl_cur; sl_cur = sl_next; sl_next = (sl_next == 2 * KRB) ? 0 : sl_next + KRB; } while (0)
#define PKW(P, B) cvtpk(P[B], P[B + 1])
#define PIN(x) asm volatile("" : "+v"(x))
#define EX(v) __builtin_amdgcn_exp2f(v)
#define VRD(i) do { vlo[i] = vtr(vp_ + ((i) >> 2) * 4096 + ((i) & 3) * 1024); vhi[i] = vtr(vp_ + ((i) >> 2) * 4096 + ((i) & 3) * 1024 + 512); } while (0)
#define VFR(i) (bf16x8){vlo[i][0], vlo[i][1], vlo[i][2], vlo[i][3], vhi[i][0], vhi[i][1], vhi[i][2], vhi[i][3]}
#define PAF(k) __builtin_bit_cast(bf16x8, pw##k)
#define GAPA(MF, W0, W1, W2, W3, PW) do { MF; W0; W1; W2; W3; PIN(PW); SBAR(); } while (0)
#define GAPB3(MF, X, B) do { MF; X[B] = EX(X[B]); X[B + 1] = EX(X[B + 1]); X[B + 2] = EX(X[B + 2]); PIN(X); SBAR(); } while (0)
#define GAPB2(MF, X, B) do { MF; X[B] = EX(X[B]); X[B + 1] = EX(X[B + 1]); PIN(X); SBAR(); } while (0)
#define KRD(G, j) do { if (G) { kf[j] = *(const LAS bf16x8*)(kp0 + sl_next + ((j) >> 1) * 2048 + ((j) & 1) * 512); SBAR(); } } while (0)
#define MFL(k) lacc = __builtin_amdgcn_mfma_f32_32x32x16_bf16(ones, PAF(k), lacc, 0, 0, 0)
#define MFO(d, i, k) o[d] = __builtin_amdgcn_mfma_f32_32x32x16_bf16(VFR(i), PAF(k), o[d], 0, 0, 0)
#define LAZY(P0, P1) do { if (__builtin_expect(__any(lacc[0] > 16777216.f), 0)) { const int e_ = lacc[0] > 16777216.f ? (int)((__float_as_uint(lacc[0]) >> 23) & 255u) - 127 : 0; \
        const float f_ = __uint_as_float((unsigned)(127 - e_) << 23); mhat += (float)e_; \
        _Pragma("unroll") for (int r = 0; r < 16; ++r) { o[0][r] *= f_; o[1][r] *= f_; lacc[r] *= f_; P0[r] *= f_; P1[r] *= f_; } SET_CFAR(); } } while (0)
#define STEP(C0, C1, P0, P1, t, GK, GV, GL) do { SBAR(); \
    { const int ns_ = SIDE_OF(t); if (ns_ != side) { side = ns_; cside = side == 0 ? cL : (side == 2 ? cR : 0.f); SET_CFAR(); } } \
    LAZY(P0, P1); \
    const LAS char* vp_ = vp0 + sl_prev; s16x4 vlo[8], vhi[8]; v4u pw0, pw1, pw2, pw3; \
    VRD(0); VRD(4); SBAR(); \
    GAPA(C0 = __builtin_amdgcn_mfma_f32_32x32x16_bf16(kf[0], qr[0], cfar, 0, 0, 0), pw0[0] = PKW(P0, 0), pw0[1] = PKW(P0, 2), pw0[2] = PKW(P0, 4), pw0[3] = PKW(P0, 6), pw0); \
    VRD(1); VRD(5); SBAR(); \
    GAPA(C1 = __builtin_amdgcn_mfma_f32_32x32x16_bf16(kf[1], qr[0], cfar, 0, 0, 0), pw1[0] = PKW(P0, 8), pw1[1] = PKW(P0, 10), pw1[2] = PKW(P0, 12), pw1[3] = PKW(P0, 14), pw1); \
    VRD(2); VRD(6); SBAR(); \
    GAPA(C0 = __builtin_amdgcn_mfma_f32_32x32x16_bf16(kf[2], qr[1], C0, 0, 0, 0), pw2[0] = PKW(P1, 0), pw2[1] = PKW(P1, 2), pw2[2] = PKW(P1, 4), pw2[3] = PKW(P1, 6), pw2); \
    VRD(3); VRD(7); SBAR(); \
    GAPA(C1 = __builtin_amdgcn_mfma_f32_32x32x16_bf16(kf[3], qr[1], C1, 0, 0, 0), pw3[0] = PKW(P1, 8), pw3[1] = PKW(P1, 10), pw3[2] = PKW(P1, 12), pw3[3] = PKW(P1, 14), pw3); \
    if (GK) DMA_K((t) + 3, sl_cur); if (GV) DMA_V((t) + 1, sl_next); \
    if (side == 1) NEAR_BIAS(C0, C1, t); \
    SBAR(); \
    GAPB3(MFO(0, 0, 0), C0, 0); GAPB3(MFO(1, 4, 0), C0, 3); GAPB2(MFL(0), C0, 6); \
    KRD(GL, 0); GAPB3(MFO(0, 1, 1), C0, 8); KRD(GL, 1); GAPB3(MFO(1, 5, 1), C0, 11); GAPB2(MFL(1), C0, 14); \
    KRD(GL, 2); GAPB3(MFO(0, 2, 2), C1, 0); KRD(GL, 3); GAPB3(MFO(1, 6, 2), C1, 3); GAPB2(MFL(2), C1, 6); \
    GAPB3(MFL(3), C1, 8); GAPB3(MFO(0, 3, 3), C1, 11); GAPB2(MFO(1, 7, 3), C1, 14); \
    } while (0)
    int t = 1;
    for (; t + 5 < NT; t += 2) {
        STEP(pB0, pB1, pA0, pA1, t, true, true, true);     WAIT_BAR(2); ROT();
        STEP(pA0, pA1, pB0, pB1, t + 1, true, true, true); WAIT_BAR(2); ROT();
    }
#define ENDW(tt) do { if ((tt) + 3 < NT) { WAIT_BAR(2); } else if ((tt) + 2 < NT) { WAIT_BAR(1); } else { WAIT_BAR(0); } } while (0)
    for (; t + 1 < NT; t += 2) {
        STEP(pB0, pB1, pA0, pA1, t, (t + 3 < NT), (t + 1 < NT), (t + 1 < NT));         ENDW(t);     ROT();
        STEP(pA0, pA1, pB0, pB1, t + 1, (t + 4 < NT), (t + 2 < NT), (t + 2 < NT));     ENDW(t + 1); ROT();
    }
    STEP(pB0, pB1, pA0, pA1, NT - 1, false, false, false);
    { LAZY(pB0, pB1);
      const v4u pw0 = {PKW(pB0, 0), PKW(pB0, 2), PKW(pB0, 4), PKW(pB0, 6)}, pw1 = {PKW(pB0, 8), PKW(pB0, 10), PKW(pB0, 12), PKW(pB0, 14)};
      const v4u pw2 = {PKW(pB1, 0), PKW(pB1, 2), PKW(pB1, 4), PKW(pB1, 6)}, pw3 = {PKW(pB1, 8), PKW(pB1, 10), PKW(pB1, 12), PKW(pB1, 14)};
      const LAS char* vp_ = vp0 + sl_cur;
#pragma unroll
      for (int k4 = 0; k4 < 4; ++k4) { const v4u pw_ = k4 == 0 ? pw0 : k4 == 1 ? pw1 : k4 == 2 ? pw2 : pw3; const bf16x8 pf_ = __builtin_bit_cast(bf16x8, pw_);
          lacc = __builtin_amdgcn_mfma_f32_32x32x16_bf16(ones, pf_, lacc, 0, 0, 0);
#pragma unroll
          for (int d0 = 0; d0 < 2; ++d0) { const s16x4 lo = vtr(vp_ + d0 * 4096 + k4 * 1024), hi4 = vtr(vp_ + d0 * 4096 + k4 * 1024 + 512);
              const bf16x8 vfr = {lo[0], lo[1], lo[2], lo[3], hi4[0], hi4[1], hi4[2], hi4[3]};
              o[d0] = __builtin_amdgcn_mfma_f32_32x32x16_bf16(vfr, pf_, o[d0], 0, 0, 0); } } }
#undef STEP
#undef PIN
#undef EX
#undef VRD
#undef VFR
#undef PAF
#undef GAPA
#undef GAPB3
#undef GAPB2
#undef MFL
#undef MFO
#undef LAZY
#undef KRD
#undef ENDW
#undef ROT
#undef PKW
#undef DMA_K
#undef DMA_V
#undef KLOAD
#undef NEAR_BIAS
#undef ROWMAX
#undef SET_CFAR
#undef SIDE_OF
    const float inv = 1.f / lacc[0];
#pragma unroll
    for (int r = 0; r < 16; ++r) { o[0][r] *= inv; o[1][r] *= inv; }
    bf16* orow = MIX + (rowbase + qrow0 + r32) * DM + ocol + 4 * hi;
    LAS float* scr = (LAS float*)(lds + L_SCR) + (wid & 3) * 2048 + lane;
    if (wid >= 4) {
#pragma unroll
        for (int d0 = 0; d0 < 2; ++d0)
#pragma unroll
            for (int r = 0; r < 16; ++r) scr[(d0 * 16 + r) * 64] = o[d0][r];
    }
    LDS_WAIT(); __builtin_amdgcn_s_barrier(); asm volatile("" ::: "memory");
    if (wid < 4) {
        const float lam = par[0], gs = par[1]; float ss = 0.f;
#pragma unroll
        for (int d0 = 0; d0 < 2; ++d0)
#pragma unroll
            for (int r = 0; r < 16; ++r) { const float d = o[d0][r] - lam * scr[(d0 * 16 + r) * 64]; o[d0][r] = d; ss += d * d; }
        ss = swapsum(ss);
        const float rs = gs / sqrtf(ss * (1.f / 64.f) + LN_EPS);
#pragma unroll
        for (int d0 = 0; d0 < 2; ++d0)
#pragma unroll
            for (int g4 = 0; g4 < 4; ++g4) { const int dv = 32 * d0 + 8 * g4 + 4 * hi; float v[4];
#pragma unroll
                for (int j = 0; j < 4; ++j) v[j] = o[d0][4 * g4 + j] * rs * par[16 + dv + j];
                u32x2 w; w.x = cvtpk(v[0], v[1]); w.y = cvtpk(v[2], v[3]); *(u32x2*)(orow + 32 * d0 + 8 * g4) = w; }
    }
    LDS_WAIT(); __builtin_amdgcn_s_barrier(); asm volatile("" ::: "memory");
}
#undef SBAR
#undef WAIT_BAR
}

struct Args { const float* in[17]; float* out; unsigned char* ws; int ph_lo, ph_hi; int coop; int pad; };
constexpr int LDS_BYTES = 147456;
constexpr int N_PHASES = 1 + 7 * DEPTH;

__device__ __forceinline__ float wave_sum(float v, int lane) {
#pragma unroll
    for (int o = 1; o < 64; o <<= 1) v += __builtin_bit_cast(float, __builtin_amdgcn_ds_bpermute((lane ^ o) << 2, __builtin_bit_cast(int, v)));
    return v;
}
__device__ __forceinline__ void transpose_item(const float* W, int K, int N, bf16* WT, LAS float* scr, int item, int lane) {
    const int nblk = N / 32, kb = item / nblk, nb = item % nblk, k0 = 64 * kb, n0 = 32 * nb;
#pragma unroll 8
    for (int i = 0; i < 32; ++i) { const int kk = 2 * i + (lane >> 5); scr[kk * 33 + (lane & 31)] = W[(size_t)(k0 + kk) * N + n0 + (lane & 31)]; }
    LDS_WAIT(); asm volatile("" ::: "memory");
    const int c = lane & 7;
#pragma unroll
    for (int j = 0; j < 4; ++j) { const int n = (lane >> 3) + 8 * j; const LAS float* s = scr + (8 * c) * 33 + n;
        v4u o; o.x = pk2(s[0 * 33], s[1 * 33]); o.y = pk2(s[2 * 33], s[3 * 33]); o.z = pk2(s[4 * 33], s[5 * 33]); o.w = pk2(s[6 * 33], s[7 * 33]);
        *(v4u*)(WT + (size_t)(n0 + n) * K + k0 + 8 * c) = o; }
    LDS_WAIT(); asm volatile("" ::: "memory");
}
__device__ __forceinline__ void ln_row(const float* xrow, const float* g, const float* bta, float* orow, bf16* brow, int lane) {
    const f32x4* xr = (const f32x4*)xrow + lane;
    f32x4 v[4]; float s = 0.f;
#pragma unroll
    for (int j = 0; j < 4; ++j) { v[j] = xr[64 * j]; s += (v[j].x + v[j].y) + (v[j].z + v[j].w); }
    const float mean = wave_sum(s, lane) * (1.f / DM); float s2 = 0.f;
#pragma unroll
    for (int j = 0; j < 4; ++j) { v[j] = v[j] - mean; s2 += (v[j].x * v[j].x + v[j].y * v[j].y) + (v[j].z * v[j].z + v[j].w * v[j].w); }
    const float rstd = 1.f / sqrtf(wave_sum(s2, lane) * (1.f / DM) + LN_EPS);
    f32x4* o4 = (f32x4*)orow + lane; unsigned long long* o8 = (unsigned long long*)brow + lane;
#pragma unroll
    for (int j = 0; j < 4; ++j) { const f32x4 gg = ((const f32x4*)g)[lane + 64 * j], bb = ((const f32x4*)bta)[lane + 64 * j];
        const f32x4 y = v[j] * rstd * gg + bb; o4[64 * j] = y;
        o8[64 * j] = (unsigned long long)pk2(y.x, y.y) | ((unsigned long long)pk2(y.z, y.w) << 32); }
}

#ifndef PROBE
#define PROBE 0
#endif
#define REP(k) for (int rep_ = 0; rep_ < ((PROBE == (k)) ? 2 : 1); ++rep_)
__global__ void __launch_bounds__(NWAVES * 64, 2) mega_fwd(Args args) {
    extern __shared__ __attribute__((aligned(16))) unsigned char lds_raw[];
    LAS unsigned char* lds = (LAS unsigned char*)lds_raw;
    const int wave = __builtin_amdgcn_readfirstlane(threadIdx.x >> 6);
    const int G = gridDim.x, bx = blockIdx.x; const int vcu = (G % 8 == 0) ? (bx % 8) * (G / 8) + bx / 8 : bx;
    typedef const __attribute__((address_space(4))) Args* kargp_t;
    kargp_t ap = (kargp_t)__builtin_amdgcn_kernarg_segment_ptr();
#define FRESH() asm volatile("" : "+s"(ap))
#define WSP(T, off) ((T*)(ap->ws + (off)))
    const float alpha = 1.4142135623730951f;
    const int gw = vcu * NWAVES + wave, NGW = G * NWAVES;
    const int lo = ap->ph_lo, hi = ap->ph_hi; const bool coop = ap->coop != 0;
#define IN(k) (lo <= (k) && (k) < hi)
#define SEAM(k) do { if (IN(k) && IN((k) + 1) && coop) { REP(7) cg::this_grid().sync(); } } while (0)
    if (IN(0)) {
        FRESH(); int lane = threadIdx.x & 63; asm volatile("" : "+v"(lane)); const float* x_in = ap->in[0]; const float* ln_in_g = ap->in[1]; const float* ln_in_b = ap->in[2];
        const float* w_in = ap->in[4]; const float* w_out = ap->in[5]; const float* w_ff1 = ap->in[13]; const float* w_ff2 = ap->in[14];
        bf16* WIN = WSP(bf16, WS_WIN); bf16* WOUT = WSP(bf16, WS_WOUT); bf16* WFF1 = WSP(bf16, WS_WFF1); bf16* WFF2 = WSP(bf16, WS_WFF2); float* X = WSP(float, WS_X); bf16* XN = WSP(bf16, WS_XN);
        LAS float* scr = (LAS float*)(lds + wave * 16384);
        constexpr int I_IN = (DM / 64) * (NPROJ / 32), I_OUT = (DM / 64) * (DM / 32), I_F1 = (DM / 64) * (FF / 32), I_F2 = (FF / 64) * (DM / 32), I_L = I_IN + I_OUT + I_F1 + I_F2;
        REP(8) for (int it = gw; it < DEPTH * I_L; it += NGW) {
            const int l = it / I_L; int r = it % I_L;
            if (r < I_IN) { transpose_item(w_in + (size_t)l * DM * NPROJ, DM, NPROJ, WIN + (size_t)l * DM * NPROJ, scr, r, lane); continue; } r -= I_IN;
            if (r < I_OUT) { transpose_item(w_out + (size_t)l * DM * DM, DM, DM, WOUT + (size_t)l * DM * DM, scr, r, lane); continue; } r -= I_OUT;
            if (r < I_F1) { transpose_item(w_ff1 + (size_t)l * DM * FF, DM, FF, WFF1 + (size_t)l * DM * FF, scr, r, lane); continue; } r -= I_F1;
            transpose_item(w_ff2 + (size_t)l * DM * FF, FF, DM, WFF2 + (size_t)l * DM * FF, scr, r, lane);
        }
        REP(9) for (int m = gw; m < MTOK; m += NGW) ln_row(x_in + (size_t)m * DM, ln_in_g, ln_in_b, X + (size_t)m * DM, XN + (size_t)m * DM, lane);
    }
    SEAM(0);
#pragma unroll
    for (int l = 0; l < DEPTH; ++l) {
        const int p0 = 1 + 7 * l;
        if (IN(p0)) {
            FRESH(); pg8::Gemm g{WSP(bf16, WS_XN), WSP(bf16, WS_WIN) + (size_t)l * DM * NPROJ, MTOK, NPROJ, DM}; pg8::StaticOrder S; S.init(MTOK, NPROJ, G, bx);
            pg8::EpiBf<0> E{WSP(bf16, WS_PROJ), NPROJ, 0.125f * LOG2E, 0.17677669529663687f * LOG2E};
            REP(3) pg8::gemm_phase<pg8::EpiBf<0>, pg8::StaticOrder, true, true>(lds, g, S, E);
        }
        SEAM(p0);
        if (IN(p0 + 1)) {
            FRESH(); att::build_tables((LAS char*)lds, ap->in[3], ap->in[6] + (size_t)l * 4 * 15 * 31, ap->in[7] + l * 8, ap->in[8] + l * 64, ap->in[9] + l * 64, ap->in[10] + l * 64, l);
            const bf16* PROJ = WSP(bf16, WS_PROJ); bf16* MIX = WSP(bf16, WS_MIX);
            if (G == 256) {
                REP(1) for (int i = 0; i < 4; ++i) att::attn_unit_c((LAS char*)lds, PROJ, MIX, (vcu >> 4) >> 2, (vcu >> 4) & 3, 4 * (vcu & 15) + i);
                REP(2) for (int i = 0; i < 4; ++i) att::attn_unit<1>((LAS char*)lds, PROJ, MIX, (vcu >> 5) >> 1, (vcu >> 5) & 1, 4 * (vcu & 31) + i);
                REP(2) for (int i = 0; i < 2; ++i) att::attn_unit<0>((LAS char*)lds, PROJ, MIX, (vcu >> 4) >> 2, (vcu >> 4) & 3, 2 * (vcu & 15) + i);
            }
        }
        SEAM(p0 + 1);
        if (IN(p0 + 2)) {
            FRESH(); pg8::Gemm g{WSP(bf16, WS_MIX), WSP(bf16, WS_WOUT) + (size_t)l * DM * DM, MTOK, DM, DM}; pg8::StaticOrder S; S.init(MTOK, DM, G, bx);
            pg8::EpiResid E{WSP(float, WS_X), ap->out, DM, alpha};
            REP(4) pg8::gemm_phase<pg8::EpiResid, pg8::StaticOrder, true, true>(lds, g, S, E);
        }
        SEAM(p0 + 2);
        if (IN(p0 + 3)) {
            FRESH(); int lane = threadIdx.x & 63; asm volatile("" : "+v"(lane)); const float* Y = ap->out; const float* gg = ap->in[11] + l * DM; const float* bb = ap->in[12] + l * DM; float* X = WSP(float, WS_X); bf16* XN = WSP(bf16, WS_XN);
            REP(6) for (int m = gw; m < MTOK; m += NGW) ln_row(Y + (size_t)m * DM, gg, bb, X + (size_t)m * DM, XN + (size_t)m * DM, lane);
        }
        SEAM(p0 + 3);
        if (IN(p0 + 4)) {
            FRESH(); pg8::Gemm g{WSP(bf16, WS_XN), WSP(bf16, WS_WFF1) + (size_t)l * DM * FF, MTOK, FF, DM}; pg8::StaticOrder S; S.init(MTOK, FF, G, bx);
            pg8::EpiBf<1> E{WSP(bf16, WS_H), FF, 1.f, 1.f};
            REP(5) pg8::gemm_phase<pg8::EpiBf<1>, pg8::StaticOrder, true, true>(lds, g, S, E);
        }
        SEAM(p0 + 4);
        if (IN(p0 + 5)) {
            FRESH(); pg8::Gemm g{WSP(bf16, WS_H), WSP(bf16, WS_WFF2) + (size_t)l * DM * FF, MTOK, DM, FF}; pg8::StaticOrder S; S.init(MTOK, DM, G, bx);
            pg8::EpiResid E{WSP(float, WS_X), ap->out, DM, alpha};
            REP(4) pg8::gemm_phase<pg8::EpiResid, pg8::StaticOrder, true, true>(lds, g, S, E);
        }
        SEAM(p0 + 5);
        if (IN(p0 + 6)) {
            FRESH(); int lane = threadIdx.x & 63; asm volatile("" : "+v"(lane)); float* Y = ap->out; const float* gg = ap->in[15] + l * DM; const float* bb = ap->in[16] + l * DM; bf16* XN = WSP(bf16, WS_XN);
            float* dst = (l == DEPTH - 1) ? Y : WSP(float, WS_X);
            for (int m = gw; m < MTOK; m += NGW) ln_row(Y + (size_t)m * DM, gg, bb, dst + (size_t)m * DM, XN + (size_t)m * DM, lane);
        }
        SEAM(p0 + 6);
    }
#undef IN
#undef SEAM
}

#ifndef MK_N_LAUNCHES
#define MK_N_LAUNCHES 1
#endif
extern "C" void kernel_launch(void* const* d_in, const int* in_sizes, int n_in, void* d_out, int out_size, void* d_ws, size_t ws_size, hipStream_t stream) {
    static int grid = 0;
    if (grid == 0) {
        if (n_in != 17 || in_sizes[0] != MTOK * DM || out_size != MTOK * DM || ws_size < WS_END) { fprintf(stderr, "kernel_launch: unexpected shapes (n_in %d, in0 %d, out %d, ws %zu); nothing launched\n", n_in, n_in > 0 ? in_sizes[0] : -1, out_size, ws_size); grid = -1; return; }
        int dev = 0, cus = 0, per_cu = 0;
        if (hipGetDevice(&dev) != hipSuccess || hipDeviceGetAttribute(&cus, hipDeviceAttributeMultiprocessorCount, dev) != hipSuccess) { grid = -1; return; }
        if (hipFuncSetAttribute((const void*)mega_fwd, hipFuncAttributeMaxDynamicSharedMemorySize, LDS_BYTES) != hipSuccess) { fprintf(stderr, "kernel_launch: hipFuncSetAttribute failed\n"); grid = -1; return; }
        if (hipOccupancyMaxActiveBlocksPerMultiprocessor(&per_cu, (const void*)mega_fwd, NWAVES * 64, LDS_BYTES) != hipSuccess || per_cu < 1) { fprintf(stderr, "kernel_launch: occupancy query says %d blocks per CU\n", per_cu); (void)hipGetLastError(); grid = -1; return; }
        grid = cus;
        if (grid != 256) fprintf(stderr, "kernel_launch: %d CUs (the attention phase is dealt for 256 workgroups)\n", grid);
    }
    if (grid < 0) return;
    Args a{};
    for (int i = 0; i < 17; ++i) a.in[i] = (const float*)d_in[i];
    a.out = (float*)d_out; a.ws = (unsigned char*)d_ws;
#if MK_N_LAUNCHES == 1
    a.ph_lo = 0; a.ph_hi = N_PHASES; a.coop = 1;
    void* kargs[] = {&a};
    hipError_t e = hipLaunchCooperativeKernel((const void*)mega_fwd, dim3(grid), dim3(NWAVES * 64), kargs, LDS_BYTES, stream);
    if (e != hipSuccess) fprintf(stderr, "kernel_launch: cooperative launch failed: %s (grid %d)\n", hipGetErrorString(e), grid);
#else
    for (int ph = 0; ph < N_PHASES; ++ph) {
        a.ph_lo = ph; a.ph_hi = ph + 1; a.coop = 0;
        hipLaunchKernelGGL(mega_fwd, dim3(grid), dim3(NWAVES * 64), LDS_BYTES, stream, a);
    }
#endif
}
```
